# Optimizing an MI355X kernel written in HIP

```python
import math
import jax, jax.numpy as jnp
from jax import lax
import numpy as np


D_MODEL = 2048
BATCH = 1
SEQ = 16384
DEPTH = 2

D_FF = 256 * ((8 * D_MODEL // 3 + 255) // 256)
W_A = D_MODEL // 4
W_B = D_MODEL // 4
GLA_HEADS = 4
GLA_DK = D_MODEL // 16
GLA_DV = D_MODEL // 8
W_CK = GLA_HEADS * GLA_DK
W_CV = GLA_HEADS * GLA_DV
GLA_RANK = 16
GLA_TAU = 16.0
GLA_CHUNK = 64
HY_ORDER = 2
HY_BANDS = 16
HY_EMB = 2 * HY_BANDS + 1
HY_HIDDEN = 64
HY_FAST_DECAY = 0.3
HY_SLOW_DECAY = 1.5
HY_TARGET = 1e-2
N_BRANCH = 3
EPS = 1e-5
SECTIONS = (W_A, W_A, W_A, W_B, W_B, W_B, W_CK, W_CK, W_CV, W_CV, GLA_RANK, GLA_RANK, D_MODEL, D_MODEL, D_MODEL)
N_IN = sum(SECTIONS)

kernel_name = 'hybrid_gated_conv_hyena_gla_encoder'


def rms_norm(x, g):
    xf = x.astype(jnp.float32)
    y = xf * lax.rsqrt(jnp.mean(xf * xf, axis=-1, keepdims=True) + EPS)
    return (y * g.astype(jnp.float32)).astype(x.dtype)


def swiglu(x, w_gu, w_down):
    g, u = jnp.split(x @ w_gu, 2, axis=-1)
    return (jax.nn.silu(g) * u) @ w_down


def conv3_centered(x, w):
    xp = jnp.pad(x, ((0, 0), (1, 1), (0, 0)))
    return xp[:, :-2] * w[0] + xp[:, 1:-1] * w[1] + xp[:, 2:] * w[2]


def split_sections(p):
    idx, acc = [], 0
    for s in SECTIONS[:-1]:
        acc += s
        idx.append(acc)
    return jnp.split(p, idx, axis=-1)


def hyena_filters(L, w1, b1, w2, b2, w3, b3, w_out, freq):
    f32 = jnp.float32
    pos = jnp.arange(L, dtype=f32)
    t = pos / max(L - 1, 1)
    bands = jnp.linspace(1e-4, HY_BANDS - 1, HY_BANDS, dtype=f32)
    ang = (2.0 * math.pi / L) * pos[:, None] * bands[None, :]
    z = jnp.concatenate([t[:, None], jnp.cos(ang), -jnp.sin(ang)], axis=-1)
    fr = freq.astype(f32)
    h = jnp.sin(fr * (z @ w1.astype(f32) + b1.astype(f32)))
    h = jnp.sin(fr * (h @ w2.astype(f32) + b2.astype(f32)))
    h = jnp.sin(fr * (h @ w3.astype(f32) + b3.astype(f32)))
    h = (h @ w_out.astype(f32)).reshape(L, HY_ORDER, 2, W_B)
    deltas = jnp.linspace(math.log(HY_TARGET) / HY_SLOW_DECAY, math.log(HY_TARGET) / HY_FAST_DECAY, W_B, dtype=f32)
    decay = jnp.exp(-t[:, None] * jnp.abs(deltas)[None, :])
    h = h * decay[:, None, None, :]
    return h / (jnp.sum(jnp.abs(h), axis=0, keepdims=True) + EPS)


def bidir_long_conv(z, h_fwd, h_bwd):
    L = z.shape[1]
    k = jnp.concatenate([h_fwd, jnp.zeros_like(h_fwd[:1]), h_bwd[:0:-1]], axis=0)
    kf = jnp.fft.rfft(k, n=2 * L, axis=0)
    zf = jnp.fft.rfft(z.astype(jnp.float32), n=2 * L, axis=1)
    y = jnp.fft.irfft(zf * kf[None], n=2 * L, axis=1)[:, :L]
    return y.astype(z.dtype)


def gla_chunked(q, k, v, g):
    f32 = jnp.float32
    bsz, nh, L, dk = q.shape
    dv = v.shape[-1]
    n = L // GLA_CHUNK
    rs = lambda a: a.reshape(bsz, nh, n, GLA_CHUNK, a.shape[-1])
    q, k, v, g = rs(q.astype(f32)), rs(k.astype(f32)), rs(v.astype(f32)), rs(g.astype(f32))
    b = jnp.cumsum(g, axis=3)
    qe = q * jnp.exp(b)
    ke = k * jnp.exp(-b)
    mask = jnp.tril(jnp.ones((GLA_CHUNK, GLA_CHUNK), dtype=bool))
    a = jnp.where(mask, jnp.einsum('bhnid,bhnjd->bhnij', qe, ke), 0.0)
    o = jnp.einsum('bhnij,bhnjv->bhniv', a, v)
    b_last = b[:, :, :, -1:, :]
    kd = k * jnp.exp(b_last - b)
    upd = jnp.einsum('bhncd,bhncv->nbhdv', kd, v)
    dec = jnp.moveaxis(jnp.exp(b_last[:, :, :, 0, :]), 2, 0)

    def step(s, inp):
        d, uu = inp
        return d[..., None] * s + uu, s

    s0 = jnp.zeros((bsz, nh, dk, dv), f32)
    _, s_prev = lax.scan(step, s0, (dec, upd))
    o = o + jnp.einsum('bhncd,nbhdv->bhncv', qe, s_prev)
    return o.reshape(bsz, nh, L, dv)


def gla_bidir(q, k, v, g_f, g_b):
    flip = lambda a: jnp.flip(a, axis=2)
    return gla_chunked(q, k, v, g_f) + flip(gla_chunked(flip(q), flip(k), flip(v), flip(g_b)))


def to_heads(a, d):
    bsz, L, _ = a.shape
    return a.reshape(bsz, L, GLA_HEADS, d).transpose(0, 2, 1, 3)


def setup_inputs(seed: int = 0) -> dict:
    key = jax.random.key(seed)
    ks = jax.random.split(key, 32)
    f32 = jnp.float32
    nrm = lambda k, shape, scale: scale * jax.random.normal(k, shape, f32)
    gain = lambda k, shape: 1.0 + 0.01 * jax.random.normal(k, shape, f32)
    D, F = D_MODEL, D_FF
    return {
        'x': jax.random.normal(ks[0], (BATCH, SEQ, D), f32),
        'ffn1_norm': gain(ks[1], (DEPTH, D)),
        'ffn1_w_gu': nrm(ks[2], (DEPTH, D, 2 * F), D ** -0.5),
        'ffn1_w_down': nrm(ks[3], (DEPTH, F, D), F ** -0.5),
        'mix_norm': gain(ks[4], (DEPTH, D)),
        'w_in': nrm(ks[5], (DEPTH, D, N_IN), D ** -0.5),
        'b_in': nrm(ks[6], (DEPTH, N_IN), 0.01),
        'conv_a': nrm(ks[7], (DEPTH, 3, W_A), 3 ** -0.5),
        'conv_b': nrm(ks[8], (DEPTH, HY_ORDER + 1, 3, W_B), 3 ** -0.5),
        'hf_w1': nrm(ks[9], (DEPTH, HY_EMB, HY_HIDDEN), HY_EMB ** -0.5),
        'hf_b1': nrm(ks[10], (DEPTH, HY_HIDDEN), 0.02),
        'hf_w2': nrm(ks[11], (DEPTH, HY_HIDDEN, HY_HIDDEN), HY_HIDDEN ** -0.5),
        'hf_b2': nrm(ks[12], (DEPTH, HY_HIDDEN), 0.02),
        'hf_w3': nrm(ks[13], (DEPTH, HY_HIDDEN, HY_HIDDEN), HY_HIDDEN ** -0.5),
        'hf_b3': nrm(ks[14], (DEPTH, HY_HIDDEN), 0.02),
        'hf_w_out': nrm(ks[15], (DEPTH, HY_HIDDEN, HY_ORDER * 2 * W_B), HY_HIDDEN ** -0.5),
        'hf_freq': gain(ks[16], (DEPTH, HY_HIDDEN)),
        'hy_skip': nrm(ks[17], (DEPTH, HY_ORDER, W_B), 0.1),
        'gk_w2': nrm(ks[18], (DEPTH, 2, GLA_RANK, W_CK), GLA_RANK ** -0.5),
        'gk_b': nrm(ks[19], (DEPTH, 2, W_CK), 0.01),
        'gla_norm': gain(ks[20], (DEPTH, GLA_DV)),
        'w_br_a': nrm(ks[21], (DEPTH, W_A, D), W_A ** -0.5),
        'w_br_b': nrm(ks[22], (DEPTH, W_B, D), W_B ** -0.5),
        'w_br_c': nrm(ks[23], (DEPTH, W_CV, D), W_CV ** -0.5),
        'w_o': nrm(ks[24], (DEPTH, D, D), D ** -0.5),
        'ffn2_norm': gain(ks[25], (DEPTH, D)),
        'ffn2_w_gu': nrm(ks[26], (DEPTH, D, 2 * F), D ** -0.5),
        'ffn2_w_down': nrm(ks[27], (DEPTH, F, D), F ** -0.5),
        'final_norm': gain(ks[28], (D,)),
    }


def reference(x, ffn1_norm, ffn1_w_gu, ffn1_w_down, mix_norm, w_in, b_in, conv_a, conv_b,
              hf_w1, hf_b1, hf_w2, hf_b2, hf_w3, hf_b3, hf_w_out, hf_freq, hy_skip,
              gk_w2, gk_b, gla_norm, w_br_a, w_br_b, w_br_c, w_o,
              ffn2_norm, ffn2_w_gu, ffn2_w_down, final_norm):
    bsz, L, _ = x.shape
    for l in range(DEPTH):
        h = x + 0.5 * swiglu(rms_norm(x, ffn1_norm[l]), ffn1_w_gu[l], ffn1_w_down[l])
        u = rms_norm(h, mix_norm[l])
        (xa, ba, ca, hv, hx1, hx2, q, k, v, r, lr_f, lr_b, ga, gb, gc) = split_sections(u @ w_in[l] + b_in[l])

        y_a = (ba * conv3_centered(ca * xa, conv_a[l])) @ w_br_a[l]

        hv = conv3_centered(hv, conv_b[l, 0])
        hx1 = conv3_centered(hx1, conv_b[l, 1])
        hx2 = conv3_centered(hx2, conv_b[l, 2])
        filt = hyena_filters(L, hf_w1[l], hf_b1[l], hf_w2[l], hf_b2[l], hf_w3[l], hf_b3[l], hf_w_out[l], hf_freq[l])
        z = hv
        for i, gate in enumerate((hx1, hx2)):
            z = gate * (bidir_long_conv(z, filt[:, i, 0], filt[:, i, 1]) + hy_skip[l, i] * z)
        y_b = z @ w_br_b[l]

        g_f = jax.nn.log_sigmoid((lr_f @ gk_w2[l, 0] + gk_b[l, 0]).astype(jnp.float32)) / GLA_TAU
        g_b = jax.nn.log_sigmoid((lr_b @ gk_w2[l, 1] + gk_b[l, 1]).astype(jnp.float32)) / GLA_TAU
        o = gla_bidir(to_heads(q, GLA_DK) * (GLA_DK ** -0.5), to_heads(k, GLA_DK), to_heads(v, GLA_DV),
                      to_heads(g_f, GLA_DK), to_heads(g_b, GLA_DK))
        o = rms_norm(o.transpose(0, 2, 1, 3).astype(u.dtype), gla_norm[l]).reshape(bsz, L, W_CV)
        y_c = (o * jax.nn.silu(r)) @ w_br_c[l]

        merged = jax.nn.sigmoid(ga) * y_a + jax.nn.sigmoid(gb) * y_b + jax.nn.sigmoid(gc) * y_c
        h = h + merged @ w_o[l]

        x = h + 0.5 * swiglu(rms_norm(h, ffn2_norm[l]), ffn2_w_gu[l], ffn2_w_down[l])
    return rms_norm(x, final_norm)
```

```cpp
#include <hip/hip_runtime.h>
#include <hip/hip_cooperative_groups.h>
#include <cstdio>
namespace cg = cooperative_groups;

#define COOP 1
#define REPK -1
#define REPN 3
#define NREP_MAIN 1

typedef unsigned short bf16_t;
typedef short bf16x8 __attribute__((ext_vector_type(8)));
typedef float f32x4 __attribute__((ext_vector_type(4)));
typedef float f32x16 __attribute__((ext_vector_type(16)));
typedef unsigned u32x4 __attribute__((ext_vector_type(4)));
typedef unsigned u32x2 __attribute__((ext_vector_type(2)));
typedef unsigned long long u64_t;
constexpr float FS_FIX = 16777216.f;

constexpr int L_ = 16384, D_ = 2048, F_ = 5632, NP_ = 12544;
constexpr float EPS_ = 1e-5f;

__device__ __forceinline__ unsigned pk2(float lo, float hi) { unsigned r; asm volatile("v_cvt_pk_bf16_f32 %0, %1, %2" : "=v"(r) : "v"(lo), "v"(hi)); return r; }
__device__ __forceinline__ bf16_t f2bf(float f) { return (bf16_t)(pk2(f, 0.f) & 0xffffu); }
__device__ __forceinline__ float bf2f(bf16_t v) { return __uint_as_float(((unsigned)v) << 16); }
__device__ __forceinline__ float bflo(unsigned w) { return __uint_as_float(w << 16); }
__device__ __forceinline__ float bfhi(unsigned w) { return __uint_as_float(w & 0xffff0000u); }
__device__ __forceinline__ void unpack8(const u32x4 w, float* o) { o[0] = bflo(w.x); o[1] = bfhi(w.x); o[2] = bflo(w.y); o[3] = bfhi(w.y); o[4] = bflo(w.z); o[5] = bfhi(w.z); o[6] = bflo(w.w); o[7] = bfhi(w.w); }
__device__ __forceinline__ float sigmoidf_(float x) { return __builtin_amdgcn_rcpf(1.f + __expf(-x)); }
__device__ __forceinline__ float siluf_(float x) { return x * sigmoidf_(x); }
__device__ __forceinline__ float fsin_rad(float x) { float r = x * 0.15915494309189535f; r -= rintf(r); return __builtin_amdgcn_sinf(r); }

__device__ __forceinline__ int ltid() { int t = threadIdx.x; asm volatile("" : "+v"(t)); return t; }
namespace pg8 {
#define PG8_LAS __attribute__((address_space(3)))
constexpr int BM = 256, BK = 64, HALF = 128, HTB = HALF * BK * 2, STAGE_BYTES = 8 * HTB, NXCD = 8, WGM = 8;
__host__ __device__ __forceinline__ int lds_byte(int r, int c) { const int st = (r >> 4) * 2 + (c >> 5), rr = r & 15, cc = c & 31, ob = rr * 64 + cc * 2; return st * 1024 + (ob ^ (((ob >> 9) & 1) << 5)); }
__host__ __device__ __forceinline__ void stage_rc(int b, int& R, int& C) { const int st = b / 1024, sb = b % 1024, swz = sb ^ (((sb >> 9) & 1) << 5); R = (st >> 1) * 16 + swz / 64; C = (st & 1) * 32 + (swz % 64) / 2; }
__host__ __device__ __forceinline__ int perm32(int rho) { const int n = rho >> 4, i = rho & 15; return 8 * (i >> 2) + 4 * n + (i & 3); }
struct Unit { int pm, pn; };
struct Gemm { const bf16_t* A; const bf16_t* Bt; int M, N, K; };
struct StaticOrder {
    int nM, nN, nwg, G, c;
    __host__ __device__ void init(int M, int N, int G_, int c_) { nM = M / BM; nN = N / BM; nwg = nM * nN; G = G_; c = c_; }
    __host__ __device__ bool next(int i, Unit& u) const {
        const long Lx = (long)i * G + c; if (Lx >= nwg) return false;
        int wgid = (int)Lx; { const int q = nwg / NXCD, r = nwg % NXCD, xcd = wgid % NXCD, off = wgid / NXCD; wgid = (xcd < r ? xcd * (q + 1) : r * (q + 1) + (xcd - r) * q) + off; }
        const int nig = WGM * nN, gid = wgid / nig, fm = gid * WGM, gsz = (nM - fm) < WGM ? (nM - fm) : WGM;
        u.pm = fm + ((wgid % nig) % gsz); u.pn = (wgid % nig) / gsz; return true;
    }
    __device__ __forceinline__ void a_ready(const Unit&) const {}
    __device__ __forceinline__ void done(const Unit&) const {}
};

template <class Epi, class Sched>
__device__ __forceinline__ void gemm_phase(PG8_LAS unsigned char* lds, const Gemm g, const Sched& S, const Epi& E) {
    int tid_ = threadIdx.x; asm volatile("" : "+v"(tid_));
    const int tid = tid_, wid = __builtin_amdgcn_readfirstlane(tid >> 6), lane = tid & 63, wr = wid >> 2, wc = wid & 3, fr = lane & 15, fq = lane >> 4;
    const int K = g.K, nt = K / BK;
    unsigned voffA[2], voffB[2];
#pragma unroll
    for (int i = 0; i < 2; ++i) { int R, C; stage_rc(tid * 16 + i * 8192, R, C); const int Rb = E.perm() ? ((R & ~31) + perm32(R & 31)) : R;
        voffA[i] = (unsigned)(R * K + C) * 2u; voffB[i] = (unsigned)(Rb * K + C) * 2u; }
    const size_t kstep = (size_t)(BK * 2);
    const size_t hstep = (size_t)HALF * K * 2;
    const size_t tstep = 2 * hstep;
    const unsigned ldsw = (unsigned)wid * 1024u;
    const int aoff = lds_byte(wr * 64 + fr, fq * 8), boff = lds_byte(wc * 32 + fr, fq * 8);
#define PG8_SA(b, h) (((b) * 2 + (h)) * HTB)
#define PG8_SB(b, h) ((4 + (b) * 2 + (h)) * HTB)
#define PG8_STAGE(bufoff, gbase, voff) do { _Pragma("unroll") for (int _i = 0; _i < 2; ++_i) \
        __builtin_amdgcn_global_load_lds((const unsigned*)((const char*)(gbase) + (voff)[_i]), (PG8_LAS unsigned*)(lds + (bufoff) + ldsw + _i * 8192), 16, 0, 0); } while (0)
#define PG8_LDA(dst, b, h) do { _Pragma("unroll") for (int m = 0; m < 4; ++m) _Pragma("unroll") for (int k = 0; k < 2; ++k) dst[m][k] = *(const PG8_LAS bf16x8*)(lds + PG8_SA(b, h) + aoff + m * 2048 + k * 1024); } while (0)
#define PG8_LDB(dst, b, h) do { _Pragma("unroll") for (int n = 0; n < 2; ++n) _Pragma("unroll") for (int k = 0; k < 2; ++k) dst[n][k] = *(const PG8_LAS bf16x8*)(lds + PG8_SB(b, h) + boff + n * 2048 + k * 1024); } while (0)
#define PG8_MMA(ai, bj, At, Bt) do { __builtin_amdgcn_s_setprio(1); _Pragma("unroll") for (int m = 0; m < 4; ++m) _Pragma("unroll") for (int n = 0; n < 2; ++n) _Pragma("unroll") for (int k = 0; k < 2; ++k) \
        acc[ai][bj][m][n] = __builtin_amdgcn_mfma_f32_16x16x32_bf16(Bt[n][k], At[m][k], acc[ai][bj][m][n], 0, 0, 0); __builtin_amdgcn_s_setprio(0); } while (0)
#define PG8_WAIT_V(n) asm volatile("s_waitcnt vmcnt(" #n ")" ::: "memory")
#define PG8_WAIT_L(n) asm volatile("s_waitcnt lgkmcnt(" #n ")" ::: "memory")
#define PG8_BAR __builtin_amdgcn_s_barrier()
#define PG8_SCHED __builtin_amdgcn_sched_barrier(0)
    Unit cur, nxt; int ui = 0;
    if (!S.next(0, cur)) return;
    f32x4 acc[2][2][4][2];
#pragma unroll
    for (int a = 0; a < 2; ++a)
#pragma unroll
        for (int b = 0; b < 2; ++b)
#pragma unroll
            for (int m = 0; m < 4; ++m)
#pragma unroll
                for (int n = 0; n < 2; ++n) acc[a][b][m][n] = (f32x4){0.f, 0.f, 0.f, 0.f};
    bf16x8 At[4][2], B0[2][2], B1[2][2];
    const char* cA = (const char*)g.A + (size_t)cur.pm * tstep; const char* cB = (const char*)g.Bt + (size_t)cur.pn * tstep;
    S.a_ready(cur);
    PG8_STAGE(PG8_SB(0, 0), cB, voffB); PG8_STAGE(PG8_SB(0, 1), cB + hstep, voffB); PG8_STAGE(PG8_SA(0, 0), cA, voffA); PG8_STAGE(PG8_SA(0, 1), cA + hstep, voffA);
    if (wr == 1) PG8_BAR;
    PG8_WAIT_V(2); PG8_BAR;
    PG8_STAGE(PG8_SB(1, 0), cB + kstep, voffB); PG8_STAGE(PG8_SA(1, 0), cA + kstep, voffA); PG8_STAGE(PG8_SB(1, 1), cB + hstep + kstep, voffB);
    PG8_WAIT_V(6); PG8_BAR;
    for (;;) {
        const bool has_next = S.next(ui + 1, nxt);
        const char* nA = has_next ? (const char*)g.A + (size_t)nxt.pm * tstep : cA; const char* nB = has_next ? (const char*)g.Bt + (size_t)nxt.pn * tstep : cB;
        for (int t = 0; t < nt; t += 2) {
            const bool last = (t == nt - 2);
            const char* a1 = cA + (size_t)(t + 1) * kstep;
            const char* a2 = last ? nA : cA + (size_t)(t + 2) * kstep; const char* b2 = last ? nB : cB + (size_t)(t + 2) * kstep;
            const char* a3 = a2 + kstep; const char* b3 = b2 + kstep;
            if (last && has_next) S.a_ready(nxt);
            PG8_LDB(B0, 0, 0); PG8_LDB(B1, 0, 1); PG8_SCHED; PG8_LDA(At, 0, 0); PG8_STAGE(PG8_SA(1, 1), a1 + hstep, voffA);
            PG8_WAIT_V(8); PG8_WAIT_L(0); PG8_BAR; PG8_MMA(0, 0, At, B0); PG8_MMA(0, 1, At, B1); PG8_BAR; PG8_SCHED;
            PG8_LDA(At, 0, 1); PG8_STAGE(PG8_SB(0, 0), b2, voffB); PG8_STAGE(PG8_SB(0, 1), b2 + hstep, voffB); PG8_STAGE(PG8_SA(0, 0), a2, voffA);
            PG8_WAIT_V(8); PG8_WAIT_L(0); PG8_BAR; PG8_MMA(1, 0, At, B0); PG8_MMA(1, 1, At, B1); PG8_BAR; PG8_SCHED;
            PG8_LDB(B0, 1, 0); PG8_LDB(B1, 1, 1); PG8_SCHED; PG8_LDA(At, 1, 0); PG8_STAGE(PG8_SA(0, 1), a2 + hstep, voffA);
            PG8_WAIT_V(8); PG8_WAIT_L(0); PG8_BAR; PG8_MMA(0, 0, At, B0); PG8_MMA(0, 1, At, B1); PG8_BAR; PG8_SCHED;
            PG8_LDA(At, 1, 1); PG8_STAGE(PG8_SB(1, 0), b3, voffB); PG8_STAGE(PG8_SB(1, 1), b3 + hstep, voffB); PG8_STAGE(PG8_SA(1, 0), a3, voffA);
            PG8_WAIT_V(8); PG8_WAIT_L(0); PG8_BAR; PG8_MMA(1, 0, At, B0); PG8_MMA(1, 1, At, B1); PG8_BAR; PG8_SCHED;
        }
        if (wr == 0) PG8_BAR;
        E(acc, cur, wr, wc, fr, fq); S.done(cur);
        if (!has_next) break;
#pragma unroll
        for (int a = 0; a < 2; ++a)
#pragma unroll
            for (int b = 0; b < 2; ++b)
#pragma unroll
                for (int m = 0; m < 4; ++m)
#pragma unroll
                    for (int n = 0; n < 2; ++n) acc[a][b][m][n] = (f32x4){0.f, 0.f, 0.f, 0.f};
        cur = nxt; cA = nA; cB = nB; ++ui;
        if (wr == 1) PG8_BAR;
    }
    PG8_WAIT_V(0);
    PG8_BAR;
#undef PG8_SA
#undef PG8_SB
#undef PG8_STAGE
#undef PG8_LDA
#undef PG8_LDB
#undef PG8_MMA
#undef PG8_WAIT_V
#undef PG8_WAIT_L
#undef PG8_BAR
#undef PG8_SCHED
}
}

constexpr size_t WS_CTL = 0;
constexpr size_t WS_FSUM = 16384;
constexpr size_t WS_WA = 49152;
constexpr size_t WS_WB = WS_WA + (size_t)11264 * 2048 * 2;
constexpr size_t WS_WC = WS_WB + (size_t)2048 * 5632 * 2;
constexpr size_t WS_WBRA = WS_WC + (size_t)NP_ * 2048 * 2;
constexpr size_t WS_WBRB = WS_WBRA + (size_t)2048 * 512 * 2;
constexpr size_t WS_WBRC = WS_WBRB + (size_t)2048 * 512 * 2;
constexpr size_t WS_WO = WS_WBRC + (size_t)2048 * 1024 * 2;
constexpr size_t WS_BIAS = WS_WO + (size_t)2048 * 2048 * 2;
constexpr size_t WS_XN = WS_BIAS + 65536;
constexpr size_t WS_P = WS_XN + (size_t)L_ * D_ * 2;
constexpr size_t WS_PA = WS_P;
constexpr size_t WS_PC = WS_PA + (size_t)L_ * 3072 * 2;
constexpr size_t WS_PG = WS_PC + (size_t)L_ * 3072 * 2;
constexpr size_t WS_PLR = WS_PG + (size_t)L_ * 6144 * 2;
constexpr size_t WS_AA = WS_PLR + (size_t)L_ * 256 * 2;
constexpr size_t WS_ZT0 = WS_AA + (size_t)L_ * 512 * 2;
constexpr size_t WS_ZT1 = WS_ZT0 + (size_t)L_ * 512 * 2;
constexpr size_t WS_Z2T = WS_ZT1 + (size_t)L_ * 512 * 2;
constexpr size_t WS_G1T = WS_Z2T + (size_t)L_ * 512 * 2;
constexpr size_t WS_G2T = WS_G1T + (size_t)L_ * 512 * 2;
constexpr size_t WS_UPD = WS_G2T + (size_t)L_ * 512 * 2;
constexpr size_t WS_DEC = WS_UPD + (size_t)8 * 256 * 32768 * 2;
constexpr size_t WS_OC = WS_DEC + (size_t)8 * 256 * 128 * 4;
constexpr size_t WS_H3 = WS_OC + (size_t)L_ * 1024 * 2;
constexpr size_t WS_END = WS_H3 + (size_t)L_ * 64 * 2;

struct EpiGU {
    static constexpr bool PERM = true, AFTER_DRAIN = false;
    unsigned char* ws;
    __device__ __forceinline__ void operator()(const f32x4 (&acc)[2][2][4][2], const pg8::Unit& u, int wr, int wc, int fr, int fq) const {
        bf16_t* H = (bf16_t*)(ws + WS_P);
        const int row0 = u.pm * 256 + wr * 64 + fr, col0 = u.pn * 128 + wc * 32 + 8 * fq;
#pragma unroll
        for (int ai = 0; ai < 2; ++ai)
#pragma unroll
            for (int m = 0; m < 4; ++m) {
                bf16_t* rowp = H + (size_t)(row0 + ai * 128 + m * 16) * F_ + col0;
                const f32x4 g0 = acc[ai][0][m][0], g1 = acc[ai][0][m][1], u0 = acc[ai][1][m][0], u1 = acc[ai][1][m][1];
                u32x4 w;
                w.x = pk2(siluf_(g0[0]) * u0[0], siluf_(g0[1]) * u0[1]); w.y = pk2(siluf_(g0[2]) * u0[2], siluf_(g0[3]) * u0[3]);
                w.z = pk2(siluf_(g1[0]) * u1[0], siluf_(g1[1]) * u1[1]); w.w = pk2(siluf_(g1[2]) * u1[2], siluf_(g1[3]) * u1[3]);
                *(u32x4*)rowp = w;
            }
    }
};
struct EpiRes {
    static constexpr bool PERM = false, AFTER_DRAIN = false;
    const float* res; float* out; float scale;
    __device__ __forceinline__ void operator()(const f32x4 (&acc)[2][2][4][2], const pg8::Unit& u, int wr, int wc, int fr, int fq) const {
        const int row0 = u.pm * 256 + wr * 64 + fr, col0 = u.pn * 256 + wc * 32 + 4 * fq;
        f32x4 cur[4], nxt[4];
        {   const size_t off = (size_t)row0 * D_ + col0;
#pragma unroll
            for (int j = 0; j < 4; ++j) cur[j] = *(const f32x4*)(res + off + (j >> 1) * 128 + (j & 1) * 16); }
#pragma unroll
        for (int g = 0; g < 8; ++g) {
            const int ai = g >> 2, m = g & 3;
            if (g < 7) { const int ai2 = (g + 1) >> 2, m2 = (g + 1) & 3; const size_t off2 = (size_t)(row0 + ai2 * 128 + m2 * 16) * D_ + col0;
#pragma unroll
                for (int j = 0; j < 4; ++j) nxt[j] = *(const f32x4*)(res + off2 + (j >> 1) * 128 + (j & 1) * 16); }
            const size_t off = (size_t)(row0 + ai * 128 + m * 16) * D_ + col0;
#pragma unroll
            for (int j = 0; j < 4; ++j) *(f32x4*)(out + off + (j >> 1) * 128 + (j & 1) * 16) = cur[j] + scale * acc[ai][j >> 1][m][j & 1];
#pragma unroll
            for (int j = 0; j < 4; ++j) cur[j] = nxt[j];
        }
    }
};
struct EpiIn {
    static constexpr bool PERM = true, AFTER_DRAIN = false;
    unsigned char* ws;
    __device__ __forceinline__ void operator()(const f32x4 (&acc)[2][2][4][2], const pg8::Unit& u, int wr, int wc, int fr, int fq) const {
        bf16_t* PA = (bf16_t*)(ws + WS_PA); bf16_t* PC = (bf16_t*)(ws + WS_PC); bf16_t* PG = (bf16_t*)(ws + WS_PG); bf16_t* PLR = (bf16_t*)(ws + WS_PLR); const float* bias = (const float*)(ws + WS_BIAS);
        bf16_t* base; int ld, ct;
        if (u.pn < 12) { base = PA; ld = 3072; ct = u.pn * 256; }
        else if (u.pn < 24) { base = PC; ld = 3072; ct = (u.pn - 12) * 256; }
        else if (u.pn < 48) { base = PG; ld = 6144; ct = (u.pn - 24) * 256; }
        else { base = PLR; ld = 256; ct = 0; }
        const int row0 = u.pm * 256 + wr * 64 + fr, cx = wc * 32 + 8 * fq;
        f32x4 bv[2][2];
#pragma unroll
        for (int bj = 0; bj < 2; ++bj)
#pragma unroll
            for (int n = 0; n < 2; ++n) bv[bj][n] = *(const f32x4*)(bias + u.pn * 256 + bj * 128 + cx + 4 * n);
#pragma unroll
        for (int ai = 0; ai < 2; ++ai)
#pragma unroll
            for (int m = 0; m < 4; ++m) {
                bf16_t* rowp = base + (size_t)(row0 + ai * 128 + m * 16) * ld + ct + cx;
#pragma unroll
                for (int bj = 0; bj < 2; ++bj) {
                    const f32x4 v0 = acc[ai][bj][m][0] + bv[bj][0], v1 = acc[ai][bj][m][1] + bv[bj][1];
                    u32x4 w; w.x = pk2(v0[0], v0[1]); w.y = pk2(v0[2], v0[3]); w.z = pk2(v1[0], v1[1]); w.w = pk2(v1[2], v1[3]);
                    *(u32x4*)(rowp + bj * 128) = w;
                }
            }
    }
};
struct EpiBr {
    static constexpr bool PERM = true, AFTER_DRAIN = false;
    unsigned char* ws; int goff; int first;
    __device__ __forceinline__ void operator()(const f32x4 (&acc)[2][2][4][2], const pg8::Unit& u, int wr, int wc, int fr, int fq) const {
        bf16_t* Mg = (bf16_t*)(ws + WS_XN); const bf16_t* gate = (const bf16_t*)(ws + WS_PG) + goff;
        const int row0 = u.pm * 256 + wr * 64 + fr, col0 = u.pn * 256 + wc * 32 + 8 * fq;
        const u32x4 z4 = (u32x4){0u, 0u, 0u, 0u};
        u32x4 gc[2], pc[2], gn[2], pn2[2];
#pragma unroll
        for (int bj = 0; bj < 2; ++bj) { gc[bj] = *(const u32x4*)(gate + (size_t)row0 * 6144 + col0 + bj * 128); pc[bj] = first ? z4 : *(const u32x4*)(Mg + (size_t)row0 * D_ + col0 + bj * 128); }
#pragma unroll
        for (int g = 0; g < 8; ++g) {
            const int ai = g >> 2, m = g & 3, row = row0 + ai * 128 + m * 16;
            if (g < 7) { const int row2 = row0 + ((g + 1) >> 2) * 128 + ((g + 1) & 3) * 16;
#pragma unroll
                for (int bj = 0; bj < 2; ++bj) { gn[bj] = *(const u32x4*)(gate + (size_t)row2 * 6144 + col0 + bj * 128); pn2[bj] = first ? z4 : *(const u32x4*)(Mg + (size_t)row2 * D_ + col0 + bj * 128); } }
#pragma unroll
            for (int bj = 0; bj < 2; ++bj) {
                float gv[8], pv[8]; unpack8(gc[bj], gv); unpack8(pc[bj], pv);
                const f32x4 a0 = acc[ai][bj][m][0], a1 = acc[ai][bj][m][1];
                u32x4 w;
                w.x = pk2(pv[0] + sigmoidf_(gv[0]) * a0[0], pv[1] + sigmoidf_(gv[1]) * a0[1]);
                w.y = pk2(pv[2] + sigmoidf_(gv[2]) * a0[2], pv[3] + sigmoidf_(gv[3]) * a0[3]);
                w.z = pk2(pv[4] + sigmoidf_(gv[4]) * a1[0], pv[5] + sigmoidf_(gv[5]) * a1[1]);
                w.w = pk2(pv[6] + sigmoidf_(gv[6]) * a1[2], pv[7] + sigmoidf_(gv[7]) * a1[3]);
                *(u32x4*)(Mg + (size_t)row * D_ + col0 + bj * 128) = w;
            }
#pragma unroll
            for (int bj = 0; bj < 2; ++bj) { gc[bj] = gn[bj]; pc[bj] = pn2[bj]; }
        }
    }
};
struct EpiAll {
    int mode;
    EpiGU gu; EpiRes rs; EpiIn in; EpiBr br;
    __device__ __forceinline__ bool perm() const { return mode != 1; }
    __device__ __forceinline__ void operator()(const f32x4 (&acc)[2][2][4][2], const pg8::Unit& u, int wr, int wc, int fr, int fq) const {
        if (mode == 0) gu(acc, u, wr, wc, fr, fq);
        else if (mode == 1) rs(acc, u, wr, wc, fr, fq);
        else if (mode == 2) in(acc, u, wr, wc, fr, fq);
        else br(acc, u, wr, wc, fr, fq);
    }
};

constexpr int LDS_BYTES = 147456;

struct Args { const float* in[29]; float* out; unsigned char* ws; int ph_lo, ph_hi; };

__device__ __forceinline__ void conv_w(const float* __restrict__ W, int K, int N, bf16_t* __restrict__ Wt, int nd64, int mode, float* tile) {
    const int tid = ltid(); const int nk4 = K >> 8; const int ntask = nk4 * nd64;
    for (int task = blockIdx.x; task < ntask; task += gridDim.x) {
        const int q = task / nk4, kt = task - q * nk4;
        int sc0, nvalid = 64;
        if (mode == 0) sc0 = q * 64;
        else if (mode == 1) { const int pn = q >> 2, sub = q & 3; sc0 = (sub >> 1) * F_ + pn * 128 + (sub & 1) * 64; }
        else { if (q < 96) sc0 = q * 64; else if (q < 192) sc0 = 6176 + (q - 96) * 64; else if (q == 192) { sc0 = 6144; nvalid = 32; } else { sc0 = 0; nvalid = 0; } }
        const int k0 = kt * 256;
        float4 v[8];
#pragma unroll
        for (int i = 0; i < 8; ++i) {
            const int r = (tid >> 4) + 32 * i, c4 = (tid & 15) * 4;
            v[i] = make_float4(0.f, 0.f, 0.f, 0.f);
            if (c4 < nvalid) v[i] = *(const float4*)(W + (size_t)(k0 + r) * N + sc0 + c4);
        }
#pragma unroll
        for (int i = 0; i < 8; ++i) {
            const int r = (tid >> 4) + 32 * i, c4 = (tid & 15) * 4;
            float* tp = tile + r * 65 + c4; tp[0] = v[i].x; tp[1] = v[i].y; tp[2] = v[i].z; tp[3] = v[i].w;
        }
        __syncthreads();
#pragma unroll
        for (int j = 0; j < 4; ++j) {
            const int n = tid >> 3, k8 = (tid & 7) * 8; const float* tp = tile + (j * 64 + k8) * 65 + n;
            u32x4 w; w.x = pk2(tp[0], tp[65]); w.y = pk2(tp[130], tp[195]); w.z = pk2(tp[260], tp[325]); w.w = pk2(tp[390], tp[455]);
            *(u32x4*)(Wt + (size_t)(q * 64 + n) * K + k0 + j * 64 + k8) = w;
        }
        __syncthreads();
    }
}

__device__ __forceinline__ void rms_rows_bf16(const float* __restrict__ src, const float* __restrict__ g, bf16_t* __restrict__ dst) {
    const int lane = ltid() & 63, wid = ltid() >> 6;
    for (int row = blockIdx.x * 8 + wid; row < L_; row += gridDim.x * 8) {
        const float* p = src + (size_t)row * D_; float4 v[8]; float ss = 0.f;
#pragma unroll
        for (int j = 0; j < 8; ++j) { v[j] = *(const float4*)(p + j * 256 + lane * 4); ss += v[j].x * v[j].x + v[j].y * v[j].y + v[j].z * v[j].z + v[j].w * v[j].w; }
#pragma unroll
        for (int o = 32; o >= 1; o >>= 1) ss += __shfl_xor(ss, o);
        const float sc = rsqrtf(ss * (1.f / 2048.f) + EPS_);
#pragma unroll
        for (int j = 0; j < 8; ++j) {
            const float4 gg = *(const float4*)(g + j * 256 + lane * 4);
            u32x2 w; w.x = pk2(v[j].x * sc * gg.x, v[j].y * sc * gg.y); w.y = pk2(v[j].z * sc * gg.z, v[j].w * sc * gg.w);
            *(u32x2*)(dst + (size_t)row * D_ + j * 256 + lane * 4) = w;
        }
    }
}
__device__ __forceinline__ void rms_rows_f32_inplace(float* __restrict__ buf, const float* __restrict__ g) {
    const int lane = ltid() & 63, wid = ltid() >> 6;
    for (int row = blockIdx.x * 8 + wid; row < L_; row += gridDim.x * 8) {
        float* p = buf + (size_t)row * D_; float4 v[8]; float ss = 0.f;
#pragma unroll
        for (int j = 0; j < 8; ++j) { v[j] = *(const float4*)(p + j * 256 + lane * 4); ss += v[j].x * v[j].x + v[j].y * v[j].y + v[j].z * v[j].z + v[j].w * v[j].w; }
#pragma unroll
        for (int o = 32; o >= 1; o >>= 1) ss += __shfl_xor(ss, o);
        const float sc = rsqrtf(ss * (1.f / 2048.f) + EPS_);
#pragma unroll
        for (int j = 0; j < 8; ++j) {
            const float4 gg = *(const float4*)(g + j * 256 + lane * 4);
            float4 o; o.x = v[j].x * sc * gg.x; o.y = v[j].y * sc * gg.y; o.z = v[j].z * sc * gg.z; o.w = v[j].w * sc * gg.w;
            *(float4*)(p + j * 256 + lane * 4) = o;
        }
    }
}

__device__ __forceinline__ void lr_proj(const bf16_t* __restrict__ XNr, const bf16_t* __restrict__ WCt, const float* __restrict__ biasp, bf16_t* __restrict__ PLR, unsigned char* sm) {
    const int tid = ltid(), lane = tid & 63, wid = tid >> 6, r = lane & 31, h = lane >> 5;
    float* part = (float*)sm;
    for (int base = blockIdx.x * 8; base < 2048; base += gridDim.x * 8) {
        f32x16 acc[2];
#pragma unroll
        for (int mi = 0; mi < 2; ++mi)
#pragma unroll
            for (int e = 0; e < 16; ++e) acc[mi][e] = 0.f;
        const bf16_t* a0 = XNr + (size_t)(base + (r & 7) + 2048 * (r >> 3)) * D_ + wid * 256 + 8 * h;
        const bf16_t* a1 = a0 + (size_t)4 * 2048 * D_;
        const bf16_t* b0 = WCt + (size_t)(12288 + r) * D_ + wid * 256 + 8 * h;
#pragma unroll 4
        for (int ks = 0; ks < 16; ++ks) {
            const bf16x8 bv = *(const bf16x8*)(b0 + ks * 16);
            const bf16x8 av0 = *(const bf16x8*)(a0 + ks * 16), av1 = *(const bf16x8*)(a1 + ks * 16);
            acc[0] = __builtin_amdgcn_mfma_f32_32x32x16_bf16(av0, bv, acc[0], 0, 0, 0);
            acc[1] = __builtin_amdgcn_mfma_f32_32x32x16_bf16(av1, bv, acc[1], 0, 0, 0);
        }
#pragma unroll
        for (int mi = 0; mi < 2; ++mi)
#pragma unroll
            for (int e = 0; e < 16; ++e) part[(wid * 64 + mi * 32 + (e & 3) + 8 * (e >> 2) + 4 * h) * 33 + r] = acc[mi][e];
        __syncthreads();
        {
            const int rr = tid >> 3, j0 = (tid & 7) * 4;
            float s[4] = {biasp[12288 + j0], biasp[12288 + j0 + 1], biasp[12288 + j0 + 2], biasp[12288 + j0 + 3]};
#pragma unroll
            for (int w = 0; w < 8; ++w)
#pragma unroll
                for (int j = 0; j < 4; ++j) s[j] += part[(w * 64 + rr) * 33 + j0 + j];
            u32x2 o; o.x = pk2(s[0], s[1]); o.y = pk2(s[2], s[3]);
            *(u32x2*)(PLR + (size_t)(base + (rr & 7) + 2048 * (rr >> 3)) * 256 + j0) = o;
        }
        __syncthreads();
    }
}

__device__ __forceinline__ void hyena_h3(const Args& a, int l, unsigned char* sm, _Float16* H3) {
    float* W1 = (float*)sm; float* W2 = W1 + 2112; float* W3 = W2 + 4096; float* B1 = W3 + 4096; float* B2 = B1 + 64; float* B3 = B2 + 64; float* FR = B3 + 64;
    float* bufA = FR + 64; float* bufB = bufA + 4160;
    const int tid = ltid();
    for (int i = tid; i < 2112; i += 512) W1[i] = a.in[9][(size_t)l * 2112 + i];
    for (int i = tid; i < 4096; i += 512) { W2[i] = a.in[11][(size_t)l * 4096 + i]; W3[i] = a.in[13][(size_t)l * 4096 + i]; }
    if (tid < 64) { B1[tid] = a.in[10][l * 64 + tid]; B2[tid] = a.in[12][l * 64 + tid]; B3[tid] = a.in[14][l * 64 + tid]; FR[tid] = a.in[16][l * 64 + tid]; }
    __syncthreads();
    const int pos = tid >> 3, q = tid & 7;
    for (int task = blockIdx.x; task < 256; task += gridDim.x) {
        const int t = task * 64 + pos; const float posf = (float)t;
        if (q == 0) bufA[pos * 65] = posf / 16383.f;
#pragma unroll
        for (int ii = 0; ii < 2; ++ii) {
            const int i = q + 8 * ii; const float band = 1e-4f + (float)i * ((15.f - 1e-4f) / 15.f);
            float rev = posf * band * (1.f / 16384.f); rev -= floorf(rev);
            bufA[pos * 65 + 1 + i] = __builtin_amdgcn_cosf(rev); bufA[pos * 65 + 17 + i] = -__builtin_amdgcn_sinf(rev);
        }
        __syncthreads();
        {   float acc[8];
#pragma unroll
            for (int jj = 0; jj < 8; ++jj) acc[jj] = B1[q * 8 + jj];
            for (int i = 0; i < 33; ++i) { const float x = bufA[pos * 65 + i];
#pragma unroll
                for (int jj = 0; jj < 8; ++jj) acc[jj] += x * W1[i * 64 + q * 8 + jj]; }
#pragma unroll
            for (int jj = 0; jj < 8; ++jj) bufB[pos * 65 + q * 8 + jj] = fsin_rad(FR[q * 8 + jj] * acc[jj]);
        }
        __syncthreads();
        {   float acc[8];
#pragma unroll
            for (int jj = 0; jj < 8; ++jj) acc[jj] = B2[q * 8 + jj];
            for (int i = 0; i < 64; ++i) { const float x = bufB[pos * 65 + i];
#pragma unroll
                for (int jj = 0; jj < 8; ++jj) acc[jj] += x * W2[i * 64 + q * 8 + jj]; }
#pragma unroll
            for (int jj = 0; jj < 8; ++jj) bufA[pos * 65 + q * 8 + jj] = fsin_rad(FR[q * 8 + jj] * acc[jj]);
        }
        __syncthreads();
        {   float acc[8];
#pragma unroll
            for (int jj = 0; jj < 8; ++jj) acc[jj] = B3[q * 8 + jj];
            for (int i = 0; i < 64; ++i) { const float x = bufA[pos * 65 + i];
#pragma unroll
                for (int jj = 0; jj < 8; ++jj) acc[jj] += x * W3[i * 64 + q * 8 + jj]; }
            typedef _Float16 h8 __attribute__((ext_vector_type(8)));
            h8 o;
#pragma unroll
            for (int jj = 0; jj < 8; ++jj) o[jj] = (_Float16)fsin_rad(FR[q * 8 + jj] * acc[jj]);
            *(h8*)(H3 + (size_t)t * 64 + q * 8) = o;
        }
        __syncthreads();
    }
}

__device__ __forceinline__ void branch_a_prep(const bf16_t* __restrict__ PA, const float* __restrict__ cw  , bf16_t* __restrict__ AA) {
#pragma unroll 2
    for (int idx = blockIdx.x * 512 + ltid(); idx < L_ * 64; idx += gridDim.x * 512) {
        const int t = idx >> 6, c8 = (idx & 63) * 8;
        const bf16_t* row = PA + (size_t)t * 3072 + c8;
        const u32x4 z4 = (u32x4){0u, 0u, 0u, 0u};
        const u32x4 xa0 = *(const u32x4*)row, ba0 = *(const u32x4*)(row + 512), ca0 = *(const u32x4*)(row + 1024);
        const u32x4 xam = t > 0 ? *(const u32x4*)(row - 3072) : z4, cam = t > 0 ? *(const u32x4*)(row - 3072 + 1024) : z4;
        const u32x4 xap = t < L_ - 1 ? *(const u32x4*)(row + 3072) : z4, cap = t < L_ - 1 ? *(const u32x4*)(row + 3072 + 1024) : z4;
        float x0[8], b0[8], c0[8], xm[8], cm[8], xp[8], cp[8];
        unpack8(xa0, x0); unpack8(ba0, b0); unpack8(ca0, c0); unpack8(xam, xm); unpack8(cam, cm); unpack8(xap, xp); unpack8(cap, cp);
        float w0[8], w1[8], w2[8];
        *(float4*)(w0) = *(const float4*)(cw + c8); *(float4*)(w0 + 4) = *(const float4*)(cw + c8 + 4);
        *(float4*)(w1) = *(const float4*)(cw + 512 + c8); *(float4*)(w1 + 4) = *(const float4*)(cw + 512 + c8 + 4);
        *(float4*)(w2) = *(const float4*)(cw + 1024 + c8); *(float4*)(w2 + 4) = *(const float4*)(cw + 1024 + c8 + 4);
        float o[8];
#pragma unroll
        for (int e = 0; e < 8; ++e) o[e] = b0[e] * (w0[e] * (cm[e] * xm[e]) + w1[e] * (c0[e] * x0[e]) + w2[e] * (cp[e] * xp[e]));
        u32x4 w; w.x = pk2(o[0], o[1]); w.y = pk2(o[2], o[3]); w.z = pk2(o[4], o[5]); w.w = pk2(o[6], o[7]);
        *(u32x4*)(AA + (size_t)t * 512 + c8) = w;
    }
}
__device__ __forceinline__ void hyena_prep(const bf16_t* __restrict__ PA, const float* __restrict__ cb  , bf16_t* ZT0, bf16_t* G1T, bf16_t* G2T) {
    const int c = ltid();
    for (int task = blockIdx.x; task < 768; task += gridDim.x) {
        const int arr = task >> 8, t0 = (task & 255) * 64;
        const float w0 = cb[(arr * 3 + 0) * 512 + c], w1 = cb[(arr * 3 + 1) * 512 + c], w2 = cb[(arr * 3 + 2) * 512 + c];
        const bf16_t* src = PA + 1536 + arr * 512 + c;
        bf16_t* dst = (arr == 0 ? ZT0 : (arr == 1 ? G1T : G2T)) + (size_t)c * L_ + t0;
        bf16_t raw[66];
#pragma unroll
        for (int k = 0; k < 66; ++k) { const int tt = t0 - 1 + k; raw[k] = (tt >= 0 && tt < L_) ? src[(size_t)tt * 3072] : (bf16_t)0; }
#pragma unroll
        for (int i8 = 0; i8 < 8; ++i8) {
            float o[8];
#pragma unroll
            for (int k = 0; k < 8; ++k) o[k] = w0 * bf2f(raw[i8 * 8 + k]) + w1 * bf2f(raw[i8 * 8 + k + 1]) + w2 * bf2f(raw[i8 * 8 + k + 2]);
            u32x4 w; w.x = pk2(o[0], o[1]); w.y = pk2(o[2], o[3]); w.z = pk2(o[4], o[5]); w.w = pk2(o[6], o[7]);
            *(u32x4*)(dst + i8 * 8) = w;
        }
    }
}

constexpr int G_GB = 0;
constexpr int G_W2 = 33024;
constexpr int G_BS = 41216;
constexpr int G_LR = 41728;
constexpr int G_TOT = 45824;
constexpr int G_QE = 47872;
constexpr int G_KE = 65280;
constexpr int G_VT = 82688;
constexpr int G_AA = 119552;
__device__ __forceinline__ void gla_b(const Args& a, int l, int hd, int dir, int t0, unsigned char* sm, const bf16_t* __restrict__ PLR) {
    float* Gb = (float*)(sm + G_GB); float* W2s = (float*)(sm + G_W2); float* Bs = (float*)(sm + G_BS); float* lrs = (float*)(sm + G_LR); float* tot = (float*)(sm + G_TOT);
    const int tid = ltid();
    const float* w2 = a.in[18] + ((size_t)(l * 2 + dir) * 16) * 512 + hd * 128;
    for (int i = tid; i < 2048; i += 512) W2s[i] = w2[(i >> 7) * 512 + (i & 127)];
    if (tid < 128) Bs[tid] = a.in[19][(l * 2 + dir) * 512 + hd * 128 + tid];
    for (int i = tid; i < 1024; i += 512) { const int j = i >> 4, r = i & 15; lrs[i] = bf2f(PLR[(size_t)(t0 + j) * 256 + dir * 16 + r]); }
    __syncthreads();
    const int d = tid & 127, q = tid >> 7;
    float run = 0.f;
    for (int k = 0; k < 16; ++k) {
        const int s = q * 16 + k, j = dir ? 63 - s : s;
        float x = Bs[d];
#pragma unroll
        for (int r = 0; r < 16; ++r) x += lrs[j * 16 + r] * W2s[r * 128 + d];
        const float g = (fminf(x, 0.f) - __logf(1.f + __expf(-fabsf(x)))) * (1.f / 16.f);
        run += g; Gb[j * 129 + d] = run;
    }
    tot[q * 128 + d] = run;
    __syncthreads();
    float off = 0.f;
    for (int qq = 0; qq < q; ++qq) off += tot[qq * 128 + d];
    if (q > 0) for (int k = 0; k < 16; ++k) { const int s = q * 16 + k, j = dir ? 63 - s : s; Gb[j * 129 + d] += off; }
    __syncthreads();
}
__device__ __forceinline__ void gla_load_vT(const bf16_t* __restrict__ PC, int hd, int t0, unsigned char* sm) {
    bf16_t* vT = (bf16_t*)(sm + G_VT);
    const int tid = ltid(), j = tid >> 3, v0 = (tid & 7) * 32;
    const bf16_t* vp = PC + (size_t)(t0 + j) * 3072 + 1024 + hd * 256 + v0;
#pragma unroll
    for (int i = 0; i < 4; ++i) {
        const u32x4 w = *(const u32x4*)(vp + i * 8);
        const int b = v0 + i * 8;
        vT[(b + 0) * 72 + j] = (bf16_t)(w.x & 0xffff); vT[(b + 1) * 72 + j] = (bf16_t)(w.x >> 16);
        vT[(b + 2) * 72 + j] = (bf16_t)(w.y & 0xffff); vT[(b + 3) * 72 + j] = (bf16_t)(w.y >> 16);
        vT[(b + 4) * 72 + j] = (bf16_t)(w.z & 0xffff); vT[(b + 5) * 72 + j] = (bf16_t)(w.z >> 16);
        vT[(b + 6) * 72 + j] = (bf16_t)(w.w & 0xffff); vT[(b + 7) * 72 + j] = (bf16_t)(w.w >> 16);
    }
}
__device__ __forceinline__ void gla_c1(const Args& a, int l, unsigned char* sm, const bf16_t* __restrict__ PC, const bf16_t* __restrict__ PLR, bf16_t* __restrict__ UPD, float* __restrict__ DEC) {
    const int tid = ltid(), lane = tid & 63, wid = tid >> 6, r = lane & 31, h = lane >> 5;
    float* Gb = (float*)(sm + G_GB); bf16_t* kdT = (bf16_t*)(sm + G_QE); bf16_t* vT = (bf16_t*)(sm + G_VT);
    for (int task = blockIdx.x; task < 2048; task += gridDim.x) {
        const int combo = task >> 8, n = task & 255, dir = combo >> 2, hd = combo & 3, t0 = n * 64;
        u32x4 kraw[2];
        { const bf16_t* kp = PC + (size_t)(t0 + (tid >> 3)) * 3072 + 512 + hd * 128 + (tid & 7) * 16; kraw[0] = *(const u32x4*)kp; kraw[1] = *(const u32x4*)(kp + 8); }
        gla_load_vT(PC, hd, t0, sm);
        gla_b(a, l, hd, dir, t0, sm, PLR);
        const int jb = dir ? 0 : 63;
        {
            const int j = tid >> 3, d0 = (tid & 7) * 16;
            float kv[16]; unpack8(kraw[0], kv); unpack8(kraw[1], kv + 8);
#pragma unroll
            for (int e = 0; e < 16; ++e) { const int d = d0 + e; kdT[d * 72 + j] = f2bf(kv[e] * __expf(Gb[jb * 129 + d] - Gb[j * 129 + d])); }
        }
        __syncthreads();
        f32x16 acc[4];
#pragma unroll
        for (int nt = 0; nt < 4; ++nt)
#pragma unroll
            for (int e = 0; e < 16; ++e) acc[nt][e] = 0.f;
#pragma unroll
        for (int ks = 0; ks < 4; ++ks) {
            const bf16x8 av = *(const bf16x8*)(vT + (32 * wid + r) * 72 + ks * 16 + 8 * h);
#pragma unroll
            for (int nt = 0; nt < 4; ++nt) { const bf16x8 bv = *(const bf16x8*)(kdT + (32 * nt + r) * 72 + ks * 16 + 8 * h); acc[nt] = __builtin_amdgcn_mfma_f32_32x32x16_bf16(av, bv, acc[nt], 0, 0, 0); }
        }
        bf16_t* up = UPD + ((size_t)(combo * 256 + n)) * 32768;
#pragma unroll
        for (int nt = 0; nt < 4; ++nt)
#pragma unroll
            for (int e = 0; e < 16; ++e) { const int dv = 32 * wid + (e & 3) + 8 * (e >> 2) + 4 * h, dk = 32 * nt + r; up[dv * 128 + dk] = f2bf(acc[nt][e]); }
        if (tid < 128) DEC[(size_t)(combo * 256 + n) * 128 + tid] = __expf(Gb[jb * 129 + tid]);
        __syncthreads();
    }
}
__device__ __forceinline__ void gla_scan(bf16_t* __restrict__ UPD, const float* __restrict__ DEC) {
    for (int idx = blockIdx.x * 512 + ltid(); idx < 131072; idx += gridDim.x * 512) {
        const int combo = idx >> 14, rem = idx & 16383, dv = rem >> 6, dk = (rem & 63) * 2, dir = combo >> 2;
        unsigned* up = (unsigned*)(UPD + (size_t)combo * 256 * 32768 + dv * 128 + dk);
        const float* dp = DEC + (size_t)combo * 256 * 128 + dk;
        float s0 = 0.f, s1 = 0.f;
        unsigned uv[8], un[8]; float2 dc[8], dn[8];
#pragma unroll
        for (int k = 0; k < 8; ++k) { const int n = dir ? 255 - k : k; uv[k] = up[(size_t)n * 16384]; dc[k] = *(const float2*)(dp + n * 128); }
        for (int nb = 0; nb < 256; nb += 8) {
            if (nb + 8 < 256) {
#pragma unroll
                for (int k = 0; k < 8; ++k) { const int n = dir ? 255 - (nb + 8 + k) : nb + 8 + k; un[k] = up[(size_t)n * 16384]; dn[k] = *(const float2*)(dp + n * 128); }
            }
#pragma unroll
            for (int k = 0; k < 8; ++k) { const int n = dir ? 255 - (nb + k) : nb + k; up[(size_t)n * 16384] = pk2(s0, s1); s0 = dc[k].x * s0 + bflo(uv[k]); s1 = dc[k].y * s1 + bfhi(uv[k]); }
#pragma unroll
            for (int k = 0; k < 8; ++k) { uv[k] = un[k]; dc[k] = dn[k]; }
        }
    }
}
__device__ __forceinline__ void gla_c3(const Args& a, int l, unsigned char* sm, const bf16_t* __restrict__ PC, const bf16_t* __restrict__ PLR, const bf16_t* __restrict__ UPD, bf16_t* __restrict__ OC) {
    const int tid = ltid(), lane = tid & 63, wid = tid >> 6, r = lane & 31, h = lane >> 5;
    float* Gb = (float*)(sm + G_GB); bf16_t* qeL = (bf16_t*)(sm + G_QE); bf16_t* keL = (bf16_t*)(sm + G_KE); bf16_t* vT = (bf16_t*)(sm + G_VT); bf16_t* Aa = (bf16_t*)(sm + G_AA);
    const float* gn = a.in[20] + l * 256;
    for (int task = blockIdx.x; task < 1024; task += gridDim.x) {
        const int hd = task >> 8, n = task & 255, t0 = n * 64;
        gla_load_vT(PC, hd, t0, sm);
        f32x16 accO[2];
#pragma unroll
        for (int mi = 0; mi < 2; ++mi)
#pragma unroll
            for (int e = 0; e < 16; ++e) accO[mi][e] = 0.f;
        for (int dir = 0; dir < 2; ++dir) {
            const bf16_t* Sg = UPD + ((size_t)((dir * 4 + hd) * 256 + n)) * 32768;
            bf16x8 sfr[8];
#pragma unroll
            for (int ks = 0; ks < 8; ++ks) sfr[ks] = *(const bf16x8*)(Sg + (32 * wid + r) * 128 + ks * 16 + 8 * h);
            u32x4 qraw[2], kraw[2];
            { const bf16_t* qp = PC + (size_t)(t0 + (tid >> 3)) * 3072 + hd * 128 + (tid & 7) * 16;
              qraw[0] = *(const u32x4*)qp; qraw[1] = *(const u32x4*)(qp + 8); kraw[0] = *(const u32x4*)(qp + 512); kraw[1] = *(const u32x4*)(qp + 520); }
            gla_b(a, l, hd, dir, t0, sm, PLR);
            {
                const int j = tid >> 3, d0 = (tid & 7) * 16;
                float qv[16], kv[16];
                unpack8(qraw[0], qv); unpack8(qraw[1], qv + 8);
                unpack8(kraw[0], kv); unpack8(kraw[1], kv + 8);
                float qo[16], ko[16];
#pragma unroll
                for (int e = 0; e < 16; ++e) { const float b = Gb[j * 129 + d0 + e]; qo[e] = qv[e] * 0.08838834764831845f * __expf(b); ko[e] = kv[e] * __expf(-b); }
                u32x4 w;
                w.x = pk2(qo[0], qo[1]); w.y = pk2(qo[2], qo[3]); w.z = pk2(qo[4], qo[5]); w.w = pk2(qo[6], qo[7]); *(u32x4*)(qeL + j * 136 + d0) = w;
                w.x = pk2(qo[8], qo[9]); w.y = pk2(qo[10], qo[11]); w.z = pk2(qo[12], qo[13]); w.w = pk2(qo[14], qo[15]); *(u32x4*)(qeL + j * 136 + d0 + 8) = w;
                w.x = pk2(ko[0], ko[1]); w.y = pk2(ko[2], ko[3]); w.z = pk2(ko[4], ko[5]); w.w = pk2(ko[6], ko[7]); *(u32x4*)(keL + j * 136 + d0) = w;
                w.x = pk2(ko[8], ko[9]); w.y = pk2(ko[10], ko[11]); w.z = pk2(ko[12], ko[13]); w.w = pk2(ko[14], ko[15]); *(u32x4*)(keL + j * 136 + d0 + 8) = w;
            }
            __syncthreads();
            if (wid < 4) {
                const int mi = wid >> 1, ni = wid & 1;
                f32x16 s;
#pragma unroll
                for (int e = 0; e < 16; ++e) s[e] = 0.f;
#pragma unroll
                for (int ks = 0; ks < 8; ++ks) {
                    const bf16x8 av = *(const bf16x8*)(qeL + (32 * mi + r) * 136 + ks * 16 + 8 * h);
                    const bf16x8 bv = *(const bf16x8*)(keL + (32 * ni + r) * 136 + ks * 16 + 8 * h);
                    s = __builtin_amdgcn_mfma_f32_32x32x16_bf16(av, bv, s, 0, 0, 0);
                }
#pragma unroll
                for (int e = 0; e < 16; ++e) { const int i = 32 * mi + (e & 3) + 8 * (e >> 2) + 4 * h, j = 32 * ni + r; const bool keep = dir ? (j >= i) : (j <= i); Aa[i * 72 + j] = f2bf(keep ? s[e] : 0.f); }
            }
            __syncthreads();
#pragma unroll
            for (int mi = 0; mi < 2; ++mi) {
#pragma unroll
                for (int ks = 0; ks < 4; ++ks) {
                    const bf16x8 av = *(const bf16x8*)(Aa + (32 * mi + r) * 72 + ks * 16 + 8 * h);
                    const bf16x8 bv = *(const bf16x8*)(vT + (32 * wid + r) * 72 + ks * 16 + 8 * h);
                    accO[mi] = __builtin_amdgcn_mfma_f32_32x32x16_bf16(av, bv, accO[mi], 0, 0, 0);
                }
#pragma unroll
                for (int ks = 0; ks < 8; ++ks) {
                    const bf16x8 av = *(const bf16x8*)(qeL + (32 * mi + r) * 136 + ks * 16 + 8 * h);
                    accO[mi] = __builtin_amdgcn_mfma_f32_32x32x16_bf16(av, sfr[ks], accO[mi], 0, 0, 0);
                }
            }
            __syncthreads();
        }
        float* Of = (float*)sm;
#pragma unroll
        for (int mi = 0; mi < 2; ++mi)
#pragma unroll
            for (int e = 0; e < 16; ++e) { const int i = 32 * mi + (e & 3) + 8 * (e >> 2) + 4 * h; Of[i * 260 + 32 * wid + r] = accO[mi][e]; }
        __syncthreads();
        bf16_t rgv[8][4];
#pragma unroll
        for (int rr = 0; rr < 8; ++rr)
#pragma unroll
            for (int q = 0; q < 4; ++q) rgv[rr][q] = PC[(size_t)(t0 + 8 * wid + rr) * 3072 + 2048 + hd * 256 + lane + 64 * q];
#pragma unroll
        for (int rr = 0; rr < 8; ++rr) {
            const int i = 8 * wid + rr, t = t0 + i;
            float v[4]; float ss = 0.f;
#pragma unroll
            for (int q = 0; q < 4; ++q) { v[q] = Of[i * 260 + lane + 64 * q]; ss += v[q] * v[q]; }
#pragma unroll
            for (int o = 32; o >= 1; o >>= 1) ss += __shfl_xor(ss, o);
            const float sc = rsqrtf(ss * (1.f / 256.f) + EPS_);
#pragma unroll
            for (int q = 0; q < 4; ++q) {
                const int col = lane + 64 * q;
                const float rg = bf2f(rgv[rr][q]);
                OC[(size_t)t * 1024 + hd * 256 + col] = f2bf(v[q] * sc * gn[col] * siluf_(rg));
            }
        }
        __syncthreads();
    }
}

constexpr int C_K = 0;
constexpr int C_Z = 65536;
constexpr int C_W = 98304;
constexpr int C_RED = 98816;
__device__ __forceinline__ void conv_build_filter(const Args& a, int l, int o, int c, unsigned char* sm, const _Float16* __restrict__ H3) {
    bf16_t* Kl = (bf16_t*)(sm + C_K); float* wl = (float*)(sm + C_W); float* red = (float*)(sm + C_RED);
    const int tid = ltid(), lane = tid & 63, wid = tid >> 6;
    const float* wo = a.in[15] + (size_t)l * 64 * 2048;
    if (tid < 128) wl[tid] = wo[(size_t)(tid & 63) * 2048 + o * 1024 + (tid >> 6) * 512 + c];
    if (tid == 0) Kl[0] = 0;
    __syncthreads();
    const float da = -3.0701134573253944f, db = -15.350567286626972f;
    const float adelta = fabsf(da + (float)c * ((db - da) / 511.f));
    float sf = 0.f, sb = 0.f;
    typedef _Float16 h8 __attribute__((ext_vector_type(8)));
    for (int i = 0; i < 32; ++i) {
        const int t = tid + 512 * i;
        const h8* hp = (const h8*)(H3 + (size_t)t * 64);
        float f = 0.f, b = 0.f;
#pragma unroll
        for (int k8 = 0; k8 < 8; ++k8) { const h8 hv = hp[k8];
#pragma unroll
            for (int e = 0; e < 8; ++e) { const float x = (float)hv[e]; f += x * wl[k8 * 8 + e]; b += x * wl[64 + k8 * 8 + e]; } }
        const float dec = __expf(-((float)t / 16383.f) * adelta);
        f *= dec; b *= dec; sf += fabsf(f); sb += fabsf(b);
        Kl[L_ + t] = f2bf(f);
        if (t > 0) Kl[L_ - t] = f2bf(b);
    }
#pragma unroll
    for (int ofs = 32; ofs >= 1; ofs >>= 1) { sf += __shfl_xor(sf, ofs); sb += __shfl_xor(sb, ofs); }
    if (lane == 0) { red[wid] = sf; red[8 + wid] = sb; }
    __syncthreads();
    float tf = 0.f, tb = 0.f;
#pragma unroll
    for (int w = 0; w < 8; ++w) { tf += red[w]; tb += red[8 + w]; }
    const float invf = 1.f / (tf + EPS_), invb = 1.f / (tb + EPS_);
    for (int x = tid; x < 32768; x += 512) { const float v = bf2f(Kl[x]); Kl[x] = f2bf(v * (x >= L_ ? invf : invb)); }
    __syncthreads();
}
__device__ __forceinline__ void hyena_conv_scalar(const Args& a, int l, int o, unsigned char* sm, const _Float16* __restrict__ H3,
                                                  const bf16_t* __restrict__ ZinT, const bf16_t* __restrict__ GT, bf16_t* __restrict__ OutT) {
    bf16_t* Kl = (bf16_t*)(sm + C_K); bf16_t* zl = (bf16_t*)(sm + C_Z);
    const int tid = ltid();
    for (int c = blockIdx.x; c < 512; c += gridDim.x) {
        conv_build_filter(a, l, o, c, sm, H3);
        for (int i = tid; i < 2048; i += 512) *(u32x4*)(zl + i * 8) = *(const u32x4*)(ZinT + (size_t)c * L_ + i * 8);
        __syncthreads();
        float acc[32];
#pragma unroll
        for (int j = 0; j < 32; ++j) acc[j] = 0.f;
        const bf16_t* kb = Kl + L_ + tid;
        for (int s = 0; s < L_; ++s) {
            const float zs = bf2f(zl[s]);
#pragma unroll
            for (int j = 0; j < 32; ++j) acc[j] += bf2f(kb[512 * j - s]) * zs;
        }
        const float skip = a.in[17][(l * 2 + o) * 512 + c];
#pragma unroll
        for (int j = 0; j < 32; ++j) {
            const int t = tid + 512 * j;
            const float zp = bf2f(zl[t]), gt = bf2f(GT[(size_t)c * L_ + t]);
            OutT[(size_t)c * L_ + t] = f2bf(gt * (acc[j] + skip * zp));
        }
        __syncthreads();
    }
}
typedef _Float16 h8_t __attribute__((ext_vector_type(8)));
__device__ __forceinline__ void hyena_filtgen(const Args& a, int l, int o, const _Float16* __restrict__ H3, bf16_t* __restrict__ FILT, u64_t* __restrict__ FSUM) {
    const int tid = ltid(), lane = tid & 63, wid = tid >> 6, r = lane & 31, h = lane >> 5;
    for (int task = blockIdx.x; task < 256; task += gridDim.x) {
        const int cg = task >> 3, part = task & 7;
        const float* wo = a.in[15] + (size_t)l * 64 * 2048 + o * 1024 + cg * 32 + r;
        h8_t wa[4];
#pragma unroll
        for (int ks = 0; ks < 4; ++ks)
#pragma unroll
            for (int e = 0; e < 8; ++e) wa[ks][e] = (_Float16)wo[(size_t)(ks * 16 + 8 * h + e) * 2048];
        const float da = -3.0701134573253944f, db = -15.350567286626972f;
        float adl[16], sabs[16];
#pragma unroll
        for (int e = 0; e < 16; ++e) { const int c = (cg * 32 + (e & 3) + 8 * (e >> 2) + 4 * h) & 511; adl[e] = fabsf(da + (float)c * ((db - da) / 511.f)) * (1.f / 16383.f); sabs[e] = 0.f; }
#pragma unroll 1
        for (int qt = 0; qt < 4; ++qt) {
            h8_t hb[2][4];
#pragma unroll
            for (int i = 0; i < 2; ++i) { const _Float16* hp = H3 + (size_t)(part * 2048 + (wid * 8 + qt * 2 + i) * 32 + r) * 64 + 8 * h;
#pragma unroll
                for (int ks = 0; ks < 4; ++ks) hb[i][ks] = *(const h8_t*)(hp + ks * 16); }
#pragma unroll
            for (int i = 0; i < 2; ++i) {
                f32x16 d;
#pragma unroll
                for (int e = 0; e < 16; ++e) d[e] = 0.f;
#pragma unroll
                for (int ks = 0; ks < 4; ++ks) d = __builtin_amdgcn_mfma_f32_32x32x16_f16(wa[ks], hb[i][ks], d, 0, 0, 0);
                const int t = part * 2048 + (wid * 8 + qt * 2 + i) * 32 + r; const float tf = (float)t;
#pragma unroll
                for (int e = 0; e < 16; ++e) {
                    const float v = d[e] * __expf(-tf * adl[e]);
                    sabs[e] += fabsf(v);
                    FILT[(size_t)(cg * 32 + (e & 3) + 8 * (e >> 2) + 4 * h) * L_ + t] = f2bf(v);
                }
            }
        }
#pragma unroll
        for (int e = 0; e < 16; ++e) {
            float s = sabs[e];
#pragma unroll
            for (int ofs = 16; ofs >= 1; ofs >>= 1) s += __shfl_xor(s, ofs);
            if (r == 0) atomicAdd(FSUM + cg * 32 + (e & 3) + 8 * (e >> 2) + 4 * h, (u64_t)(s * FS_FIX + 0.5f));
        }
    }
}
constexpr int M_PAD = 4096;
constexpr int M_ZN = L_ + 2 * M_PAD + 256;
constexpr int M_K = 0;
constexpr int M_Z = 66560;
constexpr int M_W = 119808;
constexpr int M_RED = 120320;
__device__ __forceinline__ int zpad(int idx) { return idx + ((idx >> 7) << 3); }
__device__ __forceinline__ bf16x8 ld_kfrag(const unsigned* kd, int x0, unsigned sh) {
    const int dw = x0 >> 1;
    const unsigned d0 = kd[dw], d1 = kd[dw + 1], d2 = kd[dw + 2], d3 = kd[dw + 3], d4 = kd[dw + 4];
    u32x4 o;
    o.x = __builtin_amdgcn_alignbit(d1, d0, sh); o.y = __builtin_amdgcn_alignbit(d2, d1, sh); o.z = __builtin_amdgcn_alignbit(d3, d2, sh); o.w = __builtin_amdgcn_alignbit(d4, d3, sh);
    return __builtin_bit_cast(bf16x8, o);
}
__device__ __forceinline__ unsigned swap16(unsigned w) { return (w >> 16) | (w << 16); }
__device__ __forceinline__ void hyena_conv_mfma(const Args& a, int l, int o, unsigned char* sm, const bf16_t* __restrict__ FILT, const u64_t* __restrict__ FSUM,
                                                const bf16_t* __restrict__ ZinT, const bf16_t* __restrict__ GT, bf16_t* __restrict__ OutT) {
    bf16_t* Kl = (bf16_t*)(sm + M_K); bf16_t* zp = (bf16_t*)(sm + M_Z);
    const int tid = ltid(), lane = tid & 63, wid = tid >> 6, r = lane & 31, h = lane >> 5, wk = wid >> 2, wn = wid & 3;
    for (int c = blockIdx.x; c < 512; c += gridDim.x) {
        {
            if (tid < 256) ((unsigned*)(sm + 65536))[tid] = 0u;
            if (tid == 0) Kl[0] = 0;
            const float invf = 1.f / ((float)FSUM[c] * (1.f / FS_FIX) + EPS_), invb = 1.f / ((float)FSUM[512 + c] * (1.f / FS_FIX) + EPS_);
            u32x4 fv[4];
#pragma unroll
            for (int j = 0; j < 4; ++j) fv[j] = *(const u32x4*)(FILT + (size_t)c * L_ + (tid + 512 * j) * 8);
#pragma unroll
            for (int j = 0; j < 4; ++j) {
                const int t8 = (tid + 512 * j) * 8;
                float x[8]; unpack8(fv[j], x);
                u32x4 w; w.x = pk2(x[0] * invf, x[1] * invf); w.y = pk2(x[2] * invf, x[3] * invf); w.z = pk2(x[4] * invf, x[5] * invf); w.w = pk2(x[6] * invf, x[7] * invf);
                *(u32x4*)(Kl + L_ + t8) = w;
            }
#pragma unroll
            for (int j = 0; j < 4; ++j) fv[j] = *(const u32x4*)(FILT + (size_t)(512 + c) * L_ + (tid + 512 * j) * 8);
#pragma unroll
            for (int j = 0; j < 4; ++j) {
                const int t8 = (tid + 512 * j) * 8;
                float x[8]; unpack8(fv[j], x);
#pragma unroll
                for (int e = 0; e < 8; ++e) if (t8 + e > 0) Kl[L_ - t8 - e] = f2bf(x[e] * invb);
            }
        }
        {
            u32x4 zv[7];
#pragma unroll
            for (int it = 0; it < 7; ++it) {
                const int idx0 = (tid + 512 * it) * 8; zv[it] = (u32x4){0u, 0u, 0u, 0u};
                if (idx0 >= M_PAD && idx0 < M_PAD + L_) zv[it] = *(const u32x4*)(ZinT + (size_t)c * L_ + (L_ + M_PAD - 8 - idx0));
            }
#pragma unroll
            for (int it = 0; it < 7; ++it) {
                const int idx0 = (tid + 512 * it) * 8;
                if (idx0 < M_ZN) { u32x4 w; w.x = swap16(zv[it].w); w.y = swap16(zv[it].z); w.z = swap16(zv[it].y); w.w = swap16(zv[it].x); *(u32x4*)(zp + zpad(idx0)) = w; }
            }
        }
        __syncthreads();
        const unsigned* kd = (const unsigned*)Kl;
        const int r16 = lane & 15, kg = lane >> 4;
        const int n0 = 32 * wn, sb0 = 4 * n0 + 320 * wk;
        const unsigned sh = ((1 + r16) & 1) * 16;
        const int xb = 1 + 8 * kg + r16 + 32 * sb0;
        const int zi0 = M_PAD - (n0 + r16) * 128 + 8 * kg + 32 * sb0;
        f32x4 acc[8][2];
#pragma unroll
        for (int q = 0; q < 8; ++q)
#pragma unroll
            for (int cc = 0; cc < 2; ++cc) acc[q][cc] = (f32x4){0.f, 0.f, 0.f, 0.f};
        {
        bf16x8 R[10];
#pragma unroll
        for (int m = 0; m < 6; ++m) R[m] = ld_kfrag(kd, xb + 16 * m, sh);
        unsigned ra[5], rb[5];
        { const int dwa = (xb + 16 * 6) >> 1, dwb = (xb + 16 * 7) >> 1;
#pragma unroll
          for (int e = 0; e < 5; ++e) { ra[e] = kd[dwa + e]; rb[e] = kd[dwb + e]; } }
        bf16x8 zr0 = *(const bf16x8*)(zp + zpad(zi0)), zr1 = *(const bf16x8*)(zp + zpad(zi0 - 16 * 128));
        for (int it = 0; it < 64; ++it) {
#pragma unroll
            for (int u = 0; u < 5; ++u) {
                const int j = it * 5 + u;
                { u32x4 oa, ob;
                  oa.x = __builtin_amdgcn_alignbit(ra[1], ra[0], sh); oa.y = __builtin_amdgcn_alignbit(ra[2], ra[1], sh); oa.z = __builtin_amdgcn_alignbit(ra[3], ra[2], sh); oa.w = __builtin_amdgcn_alignbit(ra[4], ra[3], sh);
                  ob.x = __builtin_amdgcn_alignbit(rb[1], rb[0], sh); ob.y = __builtin_amdgcn_alignbit(rb[2], rb[1], sh); ob.z = __builtin_amdgcn_alignbit(rb[3], rb[2], sh); ob.w = __builtin_amdgcn_alignbit(rb[4], rb[3], sh);
                  R[(2 * u + 6) % 10] = __builtin_bit_cast(bf16x8, oa); R[(2 * u + 7) % 10] = __builtin_bit_cast(bf16x8, ob); }
                const bf16x8 zb0 = zr0, zb1 = zr1;
                { const int dwa = (xb + 16 * (2 * j + 8)) >> 1, dwb = (xb + 16 * (2 * j + 9)) >> 1;
#pragma unroll
                  for (int e = 0; e < 5; ++e) { ra[e] = kd[dwa + e]; rb[e] = kd[dwb + e]; } }
                zr0 = *(const bf16x8*)(zp + zpad(zi0 + 32 * (j + 1))); zr1 = *(const bf16x8*)(zp + zpad(zi0 + 32 * (j + 1) - 16 * 128));
                __builtin_amdgcn_sched_barrier(0);
#pragma unroll
                for (int q = 0; q < 8; ++q) {
                    acc[q][0] = __builtin_amdgcn_mfma_f32_16x16x32_bf16(R[(2 * u + q) % 10], zb0, acc[q][0], 0, 0, 0);
                    acc[q][1] = __builtin_amdgcn_mfma_f32_16x16x32_bf16(R[(2 * u + q) % 10], zb1, acc[q][1], 0, 0, 0);
                }
                __builtin_amdgcn_sched_barrier(0);
            }
        }
        }
        __syncthreads();
        float* yb = (float*)(sm + M_K);
        if (wk == 0) {
#pragma unroll
            for (int q = 0; q < 8; ++q)
#pragma unroll
                for (int cc = 0; cc < 2; ++cc)
#pragma unroll
                    for (int e = 0; e < 4; ++e) yb[(n0 + 16 * cc + r16) * 129 + 16 * q + 4 * kg + e] = acc[q][cc][e];
        }
        __syncthreads();
        if (wk == 1) {
#pragma unroll
            for (int q = 0; q < 8; ++q)
#pragma unroll
                for (int cc = 0; cc < 2; ++cc)
#pragma unroll
                    for (int e = 0; e < 4; ++e) yb[(n0 + 16 * cc + r16) * 129 + 16 * q + 4 * kg + e] += acc[q][cc][e];
        }
        __syncthreads();
        const float skip = a.in[17][(l * 2 + o) * 512 + c];
        u32x4 gv4[4];
#pragma unroll
        for (int j = 0; j < 4; ++j) gv4[j] = *(const u32x4*)(GT + (size_t)c * L_ + (tid + 512 * j) * 8);
#pragma unroll
        for (int j = 0; j < 4; ++j) {
            const int t8 = (tid + 512 * j) * 8;
            const u32x4 zr = *(const u32x4*)(zp + zpad(L_ + M_PAD - 8 - t8));
            float zv[8], gg[8], ov[8];
            unpack8(zr, zv); unpack8(gv4[j], gg);
            const float* yp = yb + (t8 >> 7) * 129 + (t8 & 127);
#pragma unroll
            for (int e = 0; e < 8; ++e) ov[e] = gg[e] * (yp[e] + skip * zv[7 - e]);
            u32x4 w; w.x = pk2(ov[0], ov[1]); w.y = pk2(ov[2], ov[3]); w.z = pk2(ov[4], ov[5]); w.w = pk2(ov[6], ov[7]);
            *(u32x4*)(OutT + (size_t)c * L_ + t8) = w;
        }
        __syncthreads();
    }
}
__device__ __forceinline__ void transpose_z(const bf16_t* __restrict__ ZT, bf16_t* __restrict__ ZB, unsigned char* sm) {
    bf16_t* tile = (bf16_t*)sm;
    const int tid = ltid();
    for (int task4 = blockIdx.x; task4 < 512; task4 += gridDim.x) {
        const int c0 = (task4 >> 6) * 64, t0 = (task4 & 63) * 256;
        { const int cc = tid >> 3, t8 = (tid & 7) * 8;
          u32x4 v[4];
#pragma unroll
          for (int q = 0; q < 4; ++q) v[q] = *(const u32x4*)(ZT + (size_t)(c0 + cc) * L_ + t0 + q * 64 + t8);
#pragma unroll
          for (int q = 0; q < 4; ++q) *(u32x4*)(tile + q * 4608 + cc * 72 + t8) = v[q]; }
        __syncthreads();
        { const int tt = tid >> 3, c8 = (tid & 7) * 8;
#pragma unroll
          for (int q = 0; q < 4; ++q) {
              unsigned w[4];
#pragma unroll
              for (int k = 0; k < 4; ++k) w[k] = (unsigned)tile[q * 4608 + (c8 + 2 * k) * 72 + tt] | ((unsigned)tile[q * 4608 + (c8 + 2 * k + 1) * 72 + tt] << 16);
              *(u32x4*)(ZB + (size_t)(t0 + q * 64 + tt) * 512 + c0 + c8) = (u32x4){w[0], w[1], w[2], w[3]}; } }
        __syncthreads();
    }
}

#define XB_TMO      128
#define XB_XCNT(j)  (256  + 64 * (j))
#define XB_XSUB(j)  (1280 + 64 * (j))
#define XB_XGEN(j)  (2304 + 64 * (j))
#define XB_TOP      3328
#define XB_TOPGEN   3392
#define XCD_BAR_WORDS 3456
#define XB_SPIN_CAP (1u << 22)
__device__ __forceinline__ unsigned xb_ld(unsigned* p)              { return __hip_atomic_load(p, __ATOMIC_RELAXED, __HIP_MEMORY_SCOPE_AGENT); }
__device__ __forceinline__ unsigned xb_add(unsigned* p, unsigned v) { return __hip_atomic_fetch_add(p, v, __ATOMIC_RELAXED, __HIP_MEMORY_SCOPE_AGENT); }
__device__ __forceinline__ unsigned xb_xcc_id() { return (unsigned)__builtin_amdgcn_s_getreg((3 << 11) | 20) & 0xFu; }
#define XB_SPIN(cond, bar) do { unsigned _sp = 0; while (cond) { __builtin_amdgcn_s_sleep(1); \
    if ((++_sp & 255u) == 0u) { if (xb_ld(&(bar)[XB_TMO])) break; if (_sp > XB_SPIN_CAP) { atomicAdd(&(bar)[XB_TMO], 1u); break; } } } } while (0)
struct XcdBarrier { unsigned* bar; unsigned x; volatile PG8_LAS unsigned* st; };
__device__ __forceinline__ XcdBarrier xcd_barrier_post(unsigned* bar, volatile PG8_LAS unsigned* st) {
    XcdBarrier b; b.bar = bar; b.x = xb_xcc_id(); b.st = st;
    if (threadIdx.x == 0) (void)xb_add(&bar[XB_XCNT(b.x)], 1u);
    return b;
}
__device__ __forceinline__ void xcd_barrier_complete(unsigned* bar, unsigned x, unsigned& nloc, unsigned& nx) {
    const unsigned G = gridDim.x * gridDim.y * gridDim.z;
    unsigned sum, cnt, mine, sp = 0u;
    for (;;) {
        sum = 0u; cnt = 0u; mine = 0u;
#pragma unroll
        for (unsigned j = 0; j < 16; ++j) { const unsigned c = xb_ld(&bar[XB_XCNT(j)]); sum += c; cnt += (c > 0u) ? 1u : 0u; mine = (j == x) ? c : mine; }
        if (sum == G) break;
        __builtin_amdgcn_s_sleep(1);
        if ((++sp & 255u) == 0u) { if (xb_ld(&bar[XB_TMO])) break; if (sp > XB_SPIN_CAP) { atomicAdd(&bar[XB_TMO], 1u); break; } }
    }
    nloc = mine > 0u ? mine : 1u; nx = cnt > 0u ? cnt : 1u;
}
__device__ __forceinline__ void xcd_barrier(const XcdBarrier& b) {
    asm volatile("s_waitcnt vmcnt(0)" ::: "memory");
    __syncthreads();
    if (threadIdx.x == 0) {
        unsigned* bar = b.bar;
        __builtin_amdgcn_s_waitcnt(0);
        unsigned nloc = b.st[0], nx = b.st[1];
        if (nloc == 0u) { xcd_barrier_complete(bar, b.x, nloc, nx); b.st[0] = nloc; b.st[1] = nx; }
        const unsigned old = xb_add(&bar[XB_XSUB(b.x)], 1u);
        const unsigned gen = old / nloc;
        if (old + 1u == (gen + 1u) * nloc) {
            __builtin_amdgcn_fence(__ATOMIC_RELEASE, "agent");
            asm volatile("s_waitcnt vmcnt(0)" ::: "memory");
            const unsigned og = xb_add(&bar[XB_TOP], 1u);
            const unsigned tg = og / nx;
            if (og + 1u == (tg + 1u) * nx) xb_add(&bar[XB_TOPGEN], 1u);
            else XB_SPIN(xb_ld(&bar[XB_TOPGEN]) == tg, bar);
            __builtin_amdgcn_fence(__ATOMIC_ACQUIRE, "agent");
            xb_add(&bar[XB_XGEN(b.x)], 1u);
            asm volatile("s_waitcnt vmcnt(0)" ::: "memory");
        } else {
            XB_SPIN(xb_ld(&bar[XB_XGEN(b.x)]) == gen, bar);
            __builtin_amdgcn_fence(__ATOMIC_ACQUIRE, "agent");
            asm volatile("s_waitcnt vmcnt(0)" ::: "memory");
        }
    }
    __syncthreads();
}

__global__ void __launch_bounds__(512, 2) mega(Args a) {
    extern __shared__ __attribute__((aligned(16))) unsigned char smem[];
    cg::grid_group grid = cg::this_grid();
    PG8_LAS unsigned char* lds = (PG8_LAS unsigned char*)smem;
    const int G = gridDim.x, bid = blockIdx.x;
    volatile PG8_LAS unsigned* xst = (volatile PG8_LAS unsigned*)(lds + (LDS_BYTES - 16));
    if (threadIdx.x < 4) xst[threadIdx.x] = 0u;
    __syncthreads();
    const XcdBarrier xbar = xcd_barrier_post((unsigned*)(a.ws + WS_CTL), xst);
    for (int ph = a.ph_lo; ph < a.ph_hi && ph < 29; ++ph) {
        unsigned long long zoff = 0; asm volatile("" : "+s"(zoff));
        unsigned char* ws = a.ws + zoff;
        float* OUT = a.out;
        bf16_t* XN = (bf16_t*)(ws + WS_XN); bf16_t* PG = (bf16_t*)(ws + WS_PG);
        const int l = ph / 14, k = ph - l * 14;
        if (ph == 28) { rms_rows_f32_inplace(OUT, a.in[28]); }
        else for (int rep = 0; rep < ((ph == REPK) ? REPN : 1); ++rep) {
            if (rep) xcd_barrier(xbar);
            if (k == 0 || k == 3) {
                const int w0 = k == 0 ? 0 : 7, w1 = k == 0 ? 7 : 9;
                for (int wi = w0; wi < w1; ++wi) {
                    const float* W; int K, N, nd64, mode; size_t dof;
                    switch (wi) {
                        case 0: W = a.in[2] + (size_t)l * 2048 * 11264; K = 2048; N = 11264; dof = WS_WA; nd64 = 176; mode = 1; break;
                        case 1: W = a.in[3] + (size_t)l * 5632 * 2048; K = 5632; N = 2048; dof = WS_WB; nd64 = 32; mode = 0; break;
                        case 2: W = a.in[5] + (size_t)l * 2048 * 12320; K = 2048; N = 12320; dof = WS_WC; nd64 = 196; mode = 2; break;
                        case 3: W = a.in[21] + (size_t)l * 512 * 2048; K = 512; N = 2048; dof = WS_WBRA; nd64 = 32; mode = 0; break;
                        case 4: W = a.in[22] + (size_t)l * 512 * 2048; K = 512; N = 2048; dof = WS_WBRB; nd64 = 32; mode = 0; break;
                        case 5: W = a.in[23] + (size_t)l * 1024 * 2048; K = 1024; N = 2048; dof = WS_WBRC; nd64 = 32; mode = 0; break;
                        case 6: W = a.in[24] + (size_t)l * 2048 * 2048; K = 2048; N = 2048; dof = WS_WO; nd64 = 32; mode = 0; break;
                        case 7: W = a.in[26] + (size_t)l * 2048 * 11264; K = 2048; N = 11264; dof = WS_WA; nd64 = 176; mode = 1; break;
                        default: W = a.in[27] + (size_t)l * 5632 * 2048; K = 5632; N = 2048; dof = WS_WB; nd64 = 32; mode = 0; break;
                    }
                    conv_w(W, K, N, (bf16_t*)(ws + dof), nd64, mode, (float*)smem);
                }
            }
            if (k == 0) {
                float* BIASP = (float*)(ws + WS_BIAS);
                for (int i = bid * 512 + ltid(); i < NP_; i += G * 512) {
                    const float* b = a.in[6] + (size_t)l * 12320;
                    BIASP[i] = i < 6144 ? b[i] : (i < 12288 ? b[6176 + (i - 6144)] : (i < 12320 ? b[6144 + (i - 12288)] : 0.f));
                }
#ifndef NO_H3
                hyena_h3(a, l, smem, (_Float16*)(ws + WS_H3));
#endif
            }
            if (k == 0 || k == 3 || k == 11) {
                const float* src = (k == 0 && l == 0) ? a.in[0] : OUT;
                const float* gw = (k == 0 ? a.in[1] : (k == 3 ? a.in[4] : a.in[25])) + l * 2048;
                rms_rows_bf16(src, gw, XN);
                if (k == 3 && G == 256) {
                    asm volatile("s_waitcnt vmcnt(0)" ::: "memory"); __syncthreads();
                    lr_proj(XN, (const bf16_t*)(ws + WS_WC), (const float*)(ws + WS_BIAS), (bf16_t*)(ws + WS_PLR), smem);
                }
            }
            if (k == 5) {
                branch_a_prep((const bf16_t*)(ws + WS_PA), a.in[7] + l * 1536, (bf16_t*)(ws + WS_AA));
                hyena_prep((const bf16_t*)(ws + WS_PA), a.in[8] + l * 4608, (bf16_t*)(ws + WS_ZT0), (bf16_t*)(ws + WS_G1T), (bf16_t*)(ws + WS_G2T));
#ifndef NO_C1
                gla_c1(a, l, smem, (const bf16_t*)(ws + WS_PC), (const bf16_t*)(ws + WS_PLR), (bf16_t*)(ws + WS_UPD), (float*)(ws + WS_DEC));
                hyena_filtgen(a, l, 0, (const _Float16*)(ws + WS_H3), (bf16_t*)(ws + WS_WC), (u64_t*)(ws + WS_FSUM) + (l * 2 + 0) * 1024);
#endif
            }
            if (k == 6 && rep == 0) gla_scan((bf16_t*)(ws + WS_UPD), (const float*)(ws + WS_DEC));
            if (k == 6 || k == 7) {
                const int o = k - 6;
#ifndef NO_CONV
                if (o == 0) hyena_filtgen(a, l, 1, (const _Float16*)(ws + WS_H3), (bf16_t*)(ws + WS_PA), (u64_t*)(ws + WS_FSUM) + (l * 2 + 1) * 1024);
                hyena_conv_mfma(a, l, o, smem, (const bf16_t*)(ws + (o ? WS_PA : WS_WC)), (const u64_t*)(ws + WS_FSUM) + (l * 2 + o) * 1024, (const bf16_t*)(ws + (o ? WS_ZT1 : WS_ZT0)), (const bf16_t*)(ws + (o ? WS_G2T : WS_G1T)), (bf16_t*)(ws + (o ? WS_Z2T : WS_ZT1)));
#endif
            }
#ifndef NO_C3
            if (k == 7) gla_c3(a, l, smem, (const bf16_t*)(ws + WS_PC), (const bf16_t*)(ws + WS_PLR), (const bf16_t*)(ws + WS_UPD), (bf16_t*)(ws + WS_OC));
#endif
            if (k == 8) { transpose_z((const bf16_t*)(ws + WS_Z2T), (bf16_t*)(ws + WS_ZT0), smem); __syncthreads(); }
            const int ng = (k == 1 || k == 2 || k == 4 || k == 9 || k == 10 || k == 12 || k == 13) ? 1 : (k == 8 ? 2 : 0);
            for (int gi = 0; gi < ng; ++gi) {
                pg8::Gemm g; EpiAll E;
                g.M = L_;
                E.gu.ws = ws; E.in.ws = ws; E.br.ws = ws; E.br.goff = 0; E.br.first = 0;
                E.rs.res = OUT; E.rs.out = OUT; E.rs.scale = 1.f;
                if (k == 1 || k == 12) { g.A = XN; g.Bt = (const bf16_t*)(ws + WS_WA); g.N = 11264; g.K = 2048; E.mode = 0; }
                else if (k == 2 || k == 13) { g.A = (const bf16_t*)(ws + WS_P); g.Bt = (const bf16_t*)(ws + WS_WB); g.N = 2048; g.K = 5632; E.mode = 1; E.rs.scale = 0.5f; if (ph == 2) E.rs.res = a.in[0]; }
                else if (k == 4) { g.A = XN; g.Bt = (const bf16_t*)(ws + WS_WC); g.N = (G == 256) ? 12288 : NP_; g.K = 2048; E.mode = 2; }
                else if (k == 8 && gi == 0) { g.A = (const bf16_t*)(ws + WS_AA); g.Bt = (const bf16_t*)(ws + WS_WBRA); g.N = 2048; g.K = 512; E.mode = 3; E.br.first = 1; }
                else if (k == 8) { g.A = (const bf16_t*)(ws + WS_OC); g.Bt = (const bf16_t*)(ws + WS_WBRC); g.N = 2048; g.K = 1024; E.mode = 3; E.br.goff = 4096; }
                else if (k == 9) { g.A = (const bf16_t*)(ws + WS_ZT0); g.Bt = (const bf16_t*)(ws + WS_WBRB); g.N = 2048; g.K = 512; E.mode = 3; E.br.goff = 2048; }
                else { g.A = XN; g.Bt = (const bf16_t*)(ws + WS_WO); g.N = 2048; g.K = 2048; E.mode = 1; }
                pg8::StaticOrder S; S.init(L_, g.N, G, bid);
#ifndef NO_GEMM
                pg8::gemm_phase<EpiAll, pg8::StaticOrder>(lds, g, S, E);
#endif
            }
        }
        if (ph + 1 < a.ph_hi && ph + 1 < 29) { if (ph == a.ph_lo) grid.sync(); else xcd_barrier(xbar); }
    }
}

extern "C" void kernel_launch(void* const* d_in, const int* in_sizes, int n_in, void* d_out, int out_size, void* d_ws, size_t ws_size, hipStream_t stream) {
    static int grid_blocks = 0;
    if (!grid_blocks) {
        int dev = 0, cus = 0, per_cu = 0;
        hipGetDevice(&dev);
        hipDeviceGetAttribute(&cus, hipDeviceAttributeMultiprocessorCount, dev);
        if (hipFuncSetAttribute((const void*)mega, hipFuncAttributeMaxDynamicSharedMemorySize, LDS_BYTES) != hipSuccess) fprintf(stderr, "hipFuncSetAttribute failed\n");
        hipOccupancyMaxActiveBlocksPerMultiprocessor(&per_cu, (const void*)mega, 512, LDS_BYTES);
        (void)hipGetLastError();
        if (per_cu < 1) per_cu = 1;
        if (per_cu > 1) per_cu = 1;
        grid_blocks = cus * per_cu;
        if (ws_size < WS_END) fprintf(stderr, "workspace too small: %zu < %zu\n", ws_size, (size_t)WS_END);
    }
    Args a{};
    for (int i = 0; i < 29; ++i) a.in[i] = (const float*)d_in[i];
    a.out = (float*)d_out; a.ws = (unsigned char*)d_ws;
    (void)hipMemsetAsync((unsigned char*)d_ws + WS_CTL, 0, 49152, stream);
#if COOP
    a.ph_lo = 0; a.ph_hi = 1000;
    void* args[] = {&a};
    hipError_t e = hipLaunchCooperativeKernel((const void*)mega, dim3(grid_blocks), dim3(512), args, LDS_BYTES, stream);
    if (e != hipSuccess) fprintf(stderr, "cooperative launch failed: %s (grid %d)\n", hipGetErrorString(e), grid_blocks);
#else
    for (int p = 0; p < 29; ++p) { a.ph_lo = p; a.ph_hi = p + 1; hipLaunchKernelGGL(mega, dim3(grid_blocks), dim3(512), LDS_BYTES, stream, a); }
#endif
}
```

```cpp
#include <hip/hip_runtime.h>
#include <hip/hip_cooperative_groups.h>
#include <cstdio>
namespace cg = cooperative_groups;

#define COOP 1
#define REPK -1
#define REPN 3
#define NREP_MAIN 1

typedef unsigned short bf16_t;
typedef short bf16x8 __attribute__((ext_vector_type(8)));
typedef float f32x4 __attribute__((ext_vector_type(4)));
typedef float f32x16 __attribute__((ext_vector_type(16)));
typedef unsigned u32x4 __attribute__((ext_vector_type(4)));
typedef unsigned u32x2 __attribute__((ext_vector_type(2)));
typedef unsigned long long u64_t;
constexpr float FS_FIX = 16777216.f;

constexpr int L_ = 16384, D_ = 2048, F_ = 5632, NP_ = 12544;
constexpr float EPS_ = 1e-5f;

__device__ __forceinline__ unsigned pk2(float lo, float hi) { unsigned r; asm volatile("v_cvt_pk_bf16_f32 %0, %1, %2" : "=v"(r) : "v"(lo), "v"(hi)); return r; }
__device__ __forceinline__ bf16_t f2bf(float f) { return (bf16_t)(pk2(f, 0.f) & 0xffffu); }
__device__ __forceinline__ float bf2f(bf16_t v) { return __uint_as_float(((unsigned)v) << 16); }
__device__ __forceinline__ float bflo(unsigned w) { return __uint_as_float(w << 16); }
__device__ __forceinline__ float bfhi(unsigned w) { return __uint_as_float(w & 0xffff0000u); }
__device__ __forceinline__ void unpack8(const u32x4 w, float* o) { o[0] = bflo(w.x); o[1] = bfhi(w.x); o[2] = bflo(w.y); o[3] = bfhi(w.y); o[4] = bflo(w.z); o[5] = bfhi(w.z); o[6] = bflo(w.w); o[7] = bfhi(w.w); }
__device__ __forceinline__ float sigmoidf_(float x) { return __builtin_amdgcn_rcpf(1.f + __expf(-x)); }
__device__ __forceinline__ float siluf_(float x) { return x * sigmoidf_(x); }
__device__ __forceinline__ float fsin_rad(float x) { float r = x * 0.15915494309189535f; r -= rintf(r); return __builtin_amdgcn_sinf(r); }

__device__ __forceinline__ int ltid() { int t = threadIdx.x; asm volatile("" : "+v"(t)); return t; }
namespace pg8 {
#define PG8_LAS __attribute__((address_space(3)))
constexpr int BM = 256, BK = 64, HALF = 128, HTB = HALF * BK * 2, STAGE_BYTES = 8 * HTB, NXCD = 8, WGM = 8;
__host__ __device__ __forceinline__ int lds_byte(int r, int c) { const int st = (r >> 4) * 2 + (c >> 5), rr = r & 15, cc = c & 31, ob = rr * 64 + cc * 2; return st * 1024 + (ob ^ (((ob >> 9) & 1) << 5)); }
__host__ __device__ __forceinline__ void stage_rc(int b, int& R, int& C) { const int st = b / 1024, sb = b % 1024, swz = sb ^ (((sb >> 9) & 1) << 5); R = (st >> 1) * 16 + swz / 64; C = (st & 1) * 32 + (swz % 64) / 2; }
__host__ __device__ __forceinline__ int perm32(int rho) { const int n = rho >> 4, i = rho & 15; return 8 * (i >> 2) + 4 * n + (i & 3); }
struct Unit { int pm, pn; };
struct Gemm { const bf16_t* A; const bf16_t* Bt; int M, N, K; };
struct StaticOrder {
    int nM, nN, nwg, G, c;
    __host__ __device__ void init(int M, int N, int G_, int c_) { nM = M / BM; nN = N / BM; nwg = nM * nN; G = G_; c = c_; }
    __host__ __device__ bool next(int i, Unit& u) const {
        const long Lx = (long)i * G + c; if (Lx >= nwg) return false;
        int wgid = (int)Lx; { const int q = nwg / NXCD, r = nwg % NXCD, xcd = wgid % NXCD, off = wgid / NXCD; wgid = (xcd < r ? xcd * (q + 1) : r * (q + 1) + (xcd - r) * q) + off; }
        const int wgm = (nN == 8) ? 4 : WGM;
        const int nig = wgm * nN, gid = wgid / nig, fm = gid * wgm, gsz = (nM - fm) < wgm ? (nM - fm) : wgm;
        u.pm = fm + ((wgid % nig) % gsz); u.pn = (wgid % nig) / gsz; return true;
    }
    __device__ __forceinline__ void a_ready(const Unit&) const {}
    __device__ __forceinline__ void done(const Unit&) const {}
};

template <class Epi, class Sched>
__device__ __forceinline__ void gemm_phase(PG8_LAS unsigned char* lds, const Gemm g, const Sched& S, const Epi& E) {
    int tid_ = threadIdx.x; asm volatile("" : "+v"(tid_));
    const int tid = tid_, wid = __builtin_amdgcn_readfirstlane(tid >> 6), lane = tid & 63, wr = wid >> 2, wc = wid & 3, fr = lane & 15, fq = lane >> 4;
    const int K = g.K, nt = K / BK;
    unsigned voffA[2], voffB[2];
#pragma unroll
    for (int i = 0; i < 2; ++i) { int R, C; stage_rc(tid * 16 + i * 8192, R, C); const int Rb = E.perm() ? ((R & ~31) + perm32(R & 31)) : R;
        voffA[i] = (unsigned)(R * K + C) * 2u; voffB[i] = (unsigned)(Rb * K + C) * 2u; }
    const size_t kstep = (size_t)(BK * 2);
    const size_t hstep = (size_t)HALF * K * 2;
    const size_t tstep = 2 * hstep;
    const unsigned ldsw = (unsigned)wid * 1024u;
    const int aoff = lds_byte(wr * 64 + fr, fq * 8), boff = lds_byte(wc * 32 + fr, fq * 8);
#define PG8_SA(b, h) (((b) * 2 + (h)) * HTB)
#define PG8_SB(b, h) ((4 + (b) * 2 + (h)) * HTB)
#define PG8_STAGE(bufoff, gbase, voff) do { _Pragma("unroll") for (int _i = 0; _i < 2; ++_i) \
        __builtin_amdgcn_global_load_lds((const unsigned*)((const char*)(gbase) + (voff)[_i]), (PG8_LAS unsigned*)(lds + (bufoff) + ldsw + _i * 8192), 16, 0, 0); } while (0)
#define PG8_LDA(dst, b, h) do { _Pragma("unroll") for (int m = 0; m < 4; ++m) _Pragma("unroll") for (int k = 0; k < 2; ++k) dst[m][k] = *(const PG8_LAS bf16x8*)(lds + PG8_SA(b, h) + aoff + m * 2048 + k * 1024); } while (0)
#define PG8_LDB(dst, b, h) do { _Pragma("unroll") for (int n = 0; n < 2; ++n) _Pragma("unroll") for (int k = 0; k < 2; ++k) dst[n][k] = *(const PG8_LAS bf16x8*)(lds + PG8_SB(b, h) + boff + n * 2048 + k * 1024); } while (0)
#define PG8_MMA(ai, bj, At, Bt) do { __builtin_amdgcn_s_setprio(1); _Pragma("unroll") for (int m = 0; m < 4; ++m) _Pragma("unroll") for (int n = 0; n < 2; ++n) _Pragma("unroll") for (int k = 0; k < 2; ++k) \
        acc[ai][bj][m][n] = __builtin_amdgcn_mfma_f32_16x16x32_bf16(Bt[n][k], At[m][k], acc[ai][bj][m][n], 0, 0, 0); __builtin_amdgcn_s_setprio(0); } while (0)
#define PG8_WAIT_V(n) asm volatile("s_waitcnt vmcnt(" #n ")" ::: "memory")
#define PG8_WAIT_L(n) asm volatile("s_waitcnt lgkmcnt(" #n ")" ::: "memory")
#define PG8_BAR __builtin_amdgcn_s_barrier()
#define PG8_SCHED __builtin_amdgcn_sched_barrier(0)
    Unit cur, nxt; int ui = 0;
    if (!S.next(0, cur)) return;
    f32x4 acc[2][2][4][2];
#pragma unroll
    for (int a = 0; a < 2; ++a)
#pragma unroll
        for (int b = 0; b < 2; ++b)
#pragma unroll
            for (int m = 0; m < 4; ++m)
#pragma unroll
                for (int n = 0; n < 2; ++n) acc[a][b][m][n] = (f32x4){0.f, 0.f, 0.f, 0.f};
    bf16x8 At[4][2], B0[2][2], B1[2][2];
    const char* cA = (const char*)g.A + (size_t)cur.pm * tstep; const char* cB = (const char*)g.Bt + (size_t)cur.pn * tstep;
    S.a_ready(cur);
    PG8_STAGE(PG8_SB(0, 0), cB, voffB); PG8_STAGE(PG8_SB(0, 1), cB + hstep, voffB); PG8_STAGE(PG8_SA(0, 0), cA, voffA); PG8_STAGE(PG8_SA(0, 1), cA + hstep, voffA);
    if (wr == 1) PG8_BAR;
    PG8_WAIT_V(2); PG8_BAR;
    PG8_STAGE(PG8_SB(1, 0), cB + kstep, voffB); PG8_STAGE(PG8_SA(1, 0), cA + kstep, voffA); PG8_STAGE(PG8_SB(1, 1), cB + hstep + kstep, voffB);
    PG8_WAIT_V(6); PG8_BAR;
    for (;;) {
        const bool has_next = S.next(ui + 1, nxt);
        const char* nA = has_next ? (const char*)g.A + (size_t)nxt.pm * tstep : cA; const char* nB = has_next ? (const char*)g.Bt + (size_t)nxt.pn * tstep : cB;
        for (int t = 0; t < nt; t += 2) {
            const bool last = (t == nt - 2);
            const char* a1 = cA + (size_t)(t + 1) * kstep;
            const char* a2 = last ? nA : cA + (size_t)(t + 2) * kstep; const char* b2 = last ? nB : cB + (size_t)(t + 2) * kstep;
            const char* a3 = a2 + kstep; const char* b3 = b2 + kstep;
            if (last && has_next) S.a_ready(nxt);
            PG8_LDB(B0, 0, 0); PG8_LDB(B1, 0, 1); PG8_SCHED; PG8_LDA(At, 0, 0); PG8_STAGE(PG8_SA(1, 1), a1 + hstep, voffA);
            PG8_WAIT_V(8); PG8_WAIT_L(0); PG8_BAR; PG8_MMA(0, 0, At, B0); PG8_MMA(0, 1, At, B1); PG8_BAR; PG8_SCHED;
            PG8_LDA(At, 0, 1); PG8_STAGE(PG8_SB(0, 0), b2, voffB); PG8_STAGE(PG8_SB(0, 1), b2 + hstep, voffB); PG8_STAGE(PG8_SA(0, 0), a2, voffA);
            PG8_WAIT_V(8); PG8_WAIT_L(0); PG8_BAR; PG8_MMA(1, 0, At, B0); PG8_MMA(1, 1, At, B1); PG8_BAR; PG8_SCHED;
            PG8_LDB(B0, 1, 0); PG8_LDB(B1, 1, 1); PG8_SCHED; PG8_LDA(At, 1, 0); PG8_STAGE(PG8_SA(0, 1), a2 + hstep, voffA);
            PG8_WAIT_V(8); PG8_WAIT_L(0); PG8_BAR; PG8_MMA(0, 0, At, B0); PG8_MMA(0, 1, At, B1); PG8_BAR; PG8_SCHED;
            PG8_LDA(At, 1, 1); PG8_STAGE(PG8_SB(1, 0), b3, voffB); PG8_STAGE(PG8_SB(1, 1), b3 + hstep, voffB); PG8_STAGE(PG8_SA(1, 0), a3, voffA);
            PG8_WAIT_V(8); PG8_WAIT_L(0); PG8_BAR; PG8_MMA(1, 0, At, B0); PG8_MMA(1, 1, At, B1); PG8_BAR; PG8_SCHED;
        }
        if (wr == 0) PG8_BAR;
        E(acc, cur, wr, wc, fr, fq); S.done(cur);
        if (!has_next) break;
#pragma unroll
        for (int a = 0; a < 2; ++a)
#pragma unroll
            for (int b = 0; b < 2; ++b)
#pragma unroll
                for (int m = 0; m < 4; ++m)
#pragma unroll
                    for (int n = 0; n < 2; ++n) acc[a][b][m][n] = (f32x4){0.f, 0.f, 0.f, 0.f};
        cur = nxt; cA = nA; cB = nB; ++ui;
        if (wr == 1) PG8_BAR;
    }
    PG8_WAIT_V(0);
    PG8_BAR;
#undef PG8_SA
#undef PG8_SB
#undef PG8_STAGE
#undef PG8_LDA
#undef PG8_LDB
#undef PG8_MMA
#undef PG8_WAIT_V
#undef PG8_WAIT_L
#undef PG8_BAR
#undef PG8_SCHED
}
}

struct EpiGU {
    static constexpr bool PERM = true, AFTER_DRAIN = false;
    bf16_t* H;
    __device__ __forceinline__ void operator()(const f32x4 (&acc)[2][2][4][2], const pg8::Unit& u, int wr, int wc, int fr, int fq) const {
        const int row0 = u.pm * 256 + wr * 64 + fr, col0 = u.pn * 128 + wc * 32 + 8 * fq;
#pragma unroll
        for (int ai = 0; ai < 2; ++ai)
#pragma unroll
            for (int m = 0; m < 4; ++m) {
                bf16_t* rowp = H + (size_t)(row0 + ai * 128 + m * 16) * F_ + col0;
                const f32x4 g0 = acc[ai][0][m][0], g1 = acc[ai][0][m][1], u0 = acc[ai][1][m][0], u1 = acc[ai][1][m][1];
                u32x4 w;
                w.x = pk2(siluf_(g0[0]) * u0[0], siluf_(g0[1]) * u0[1]); w.y = pk2(siluf_(g0[2]) * u0[2], siluf_(g0[3]) * u0[3]);
                w.z = pk2(siluf_(g1[0]) * u1[0], siluf_(g1[1]) * u1[1]); w.w = pk2(siluf_(g1[2]) * u1[2], siluf_(g1[3]) * u1[3]);
                *(u32x4*)rowp = w;
            }
    }
};
struct EpiRes {
    static constexpr bool PERM = false, AFTER_DRAIN = false;
    const float* res; float* out; float scale;
    __device__ __forceinline__ void operator()(const f32x4 (&acc)[2][2][4][2], const pg8::Unit& u, int wr, int wc, int fr, int fq) const {
        const int row0 = u.pm * 256 + wr * 64 + fr, col0 = u.pn * 256 + wc * 32 + 4 * fq;
        f32x4 cur[4], nxt[4];
        {   const size_t off = (size_t)row0 * D_ + col0;
#pragma unroll
            for (int j = 0; j < 4; ++j) cur[j] = *(const f32x4*)(res + off + (j >> 1) * 128 + (j & 1) * 16); }
#pragma unroll
        for (int g = 0; g < 8; ++g) {
            const int ai = g >> 2, m = g & 3;
            if (g < 7) { const int ai2 = (g + 1) >> 2, m2 = (g + 1) & 3; const size_t off2 = (size_t)(row0 + ai2 * 128 + m2 * 16) * D_ + col0;
#pragma unroll
                for (int j = 0; j < 4; ++j) nxt[j] = *(const f32x4*)(res + off2 + (j >> 1) * 128 + (j & 1) * 16); }
            const size_t off = (size_t)(row0 + ai * 128 + m * 16) * D_ + col0;
#pragma unroll
            for (int j = 0; j < 4; ++j) *(f32x4*)(out + off + (j >> 1) * 128 + (j & 1) * 16) = cur[j] + scale * acc[ai][j >> 1][m][j & 1];
#pragma unroll
            for (int j = 0; j < 4; ++j) cur[j] = nxt[j];
        }
    }
};
struct EpiIn {
    static constexpr bool PERM = true, AFTER_DRAIN = false;
    bf16_t *PA, *PC, *PG, *PLR; const float* bias;
    __device__ __forceinline__ void operator()(const f32x4 (&acc)[2][2][4][2], const pg8::Unit& u, int wr, int wc, int fr, int fq) const {
        bf16_t* base; int ld, ct;
        if (u.pn < 12) { base = PA; ld = 3072; ct = u.pn * 256; }
        else if (u.pn < 24) { base = PC; ld = 3072; ct = (u.pn - 12) * 256; }
        else if (u.pn < 48) { base = PG; ld = 6144; ct = (u.pn - 24) * 256; }
        else { base = PLR; ld = 256; ct = 0; }
        const int row0 = u.pm * 256 + wr * 64 + fr, cx = wc * 32 + 8 * fq;
        f32x4 bv[2][2];
#pragma unroll
        for (int bj = 0; bj < 2; ++bj)
#pragma unroll
            for (int n = 0; n < 2; ++n) bv[bj][n] = *(const f32x4*)(bias + u.pn * 256 + bj * 128 + cx + 4 * n);
#pragma unroll
        for (int ai = 0; ai < 2; ++ai)
#pragma unroll
            for (int m = 0; m < 4; ++m) {
                bf16_t* rowp = base + (size_t)(row0 + ai * 128 + m * 16) * ld + ct + cx;
#pragma unroll
                for (int bj = 0; bj < 2; ++bj) {
                    const f32x4 v0 = acc[ai][bj][m][0] + bv[bj][0], v1 = acc[ai][bj][m][1] + bv[bj][1];
                    u32x4 w; w.x = pk2(v0[0], v0[1]); w.y = pk2(v0[2], v0[3]); w.z = pk2(v1[0], v1[1]); w.w = pk2(v1[2], v1[3]);
                    *(u32x4*)(rowp + bj * 128) = w;
                }
            }
    }
};
struct EpiBr {
    static constexpr bool PERM = true, AFTER_DRAIN = false;
    bf16_t* Mg; const bf16_t* gate; int first;
    __device__ __forceinline__ void operator()(const f32x4 (&acc)[2][2][4][2], const pg8::Unit& u, int wr, int wc, int fr, int fq) const {
        const int row0 = u.pm * 256 + wr * 64 + fr, col0 = u.pn * 256 + wc * 32 + 8 * fq;
        const u32x4 z4 = (u32x4){0u, 0u, 0u, 0u};
        u32x4 gc[2], pc[2], gn[2], pn2[2];
#pragma unroll
        for (int bj = 0; bj < 2; ++bj) { gc[bj] = *(const u32x4*)(gate + (size_t)row0 * 6144 + col0 + bj * 128); pc[bj] = first ? z4 : *(const u32x4*)(Mg + (size_t)row0 * D_ + col0 + bj * 128); }
#pragma unroll
        for (int g = 0; g < 8; ++g) {
            const int ai = g >> 2, m = g & 3, row = row0 + ai * 128 + m * 16;
            if (g < 7) { const int row2 = row0 + ((g + 1) >> 2) * 128 + ((g + 1) & 3) * 16;
#pragma unroll
                for (int bj = 0; bj < 2; ++bj) { gn[bj] = *(const u32x4*)(gate + (size_t)row2 * 6144 + col0 + bj * 128); pn2[bj] = first ? z4 : *(const u32x4*)(Mg + (size_t)row2 * D_ + col0 + bj * 128); } }
#pragma unroll
            for (int bj = 0; bj < 2; ++bj) {
                float gv[8], pv[8]; unpack8(gc[bj], gv); unpack8(pc[bj], pv);
                const f32x4 a0 = acc[ai][bj][m][0], a1 = acc[ai][bj][m][1];
                u32x4 w;
                w.x = pk2(pv[0] + sigmoidf_(gv[0]) * a0[0], pv[1] + sigmoidf_(gv[1]) * a0[1]);
                w.y = pk2(pv[2] + sigmoidf_(gv[2]) * a0[2], pv[3] + sigmoidf_(gv[3]) * a0[3]);
                w.z = pk2(pv[4] + sigmoidf_(gv[4]) * a1[0], pv[5] + sigmoidf_(gv[5]) * a1[1]);
                w.w = pk2(pv[6] + sigmoidf_(gv[6]) * a1[2], pv[7] + sigmoidf_(gv[7]) * a1[3]);
                *(u32x4*)(Mg + (size_t)row * D_ + col0 + bj * 128) = w;
            }
#pragma unroll
            for (int bj = 0; bj < 2; ++bj) { gc[bj] = gn[bj]; pc[bj] = pn2[bj]; }
        }
    }
};
struct EpiAll {
    int mode;
    EpiGU gu; EpiRes rs; EpiIn in; EpiBr br;
    __device__ __forceinline__ bool perm() const { return mode != 1; }
    __device__ __forceinline__ void operator()(const f32x4 (&acc)[2][2][4][2], const pg8::Unit& u, int wr, int wc, int fr, int fq) const {
        if (mode == 0) gu(acc, u, wr, wc, fr, fq);
        else if (mode == 1) rs(acc, u, wr, wc, fr, fq);
        else if (mode == 2) in(acc, u, wr, wc, fr, fq);
        else br(acc, u, wr, wc, fr, fq);
    }
};

constexpr size_t WS_CTL = 0;
constexpr size_t WS_FSUM = 16384;
constexpr size_t WS_WA = 49152;
constexpr size_t WS_WB = WS_WA + (size_t)11264 * 2048 * 2;
constexpr size_t WS_WC = WS_WB + (size_t)2048 * 5632 * 2;
constexpr size_t WS_WBRA = WS_WC + (size_t)NP_ * 2048 * 2;
constexpr size_t WS_WBRB = WS_WBRA + (size_t)2048 * 512 * 2;
constexpr size_t WS_WBRC = WS_WBRB + (size_t)2048 * 512 * 2;
constexpr size_t WS_WO = WS_WBRC + (size_t)2048 * 1024 * 2;
constexpr size_t WS_BIAS = WS_WO + (size_t)2048 * 2048 * 2;
constexpr size_t WS_XN = WS_BIAS + 65536;
constexpr size_t WS_P = WS_XN + (size_t)L_ * D_ * 2;
constexpr size_t WS_PA = WS_P;
constexpr size_t WS_PC = WS_PA + (size_t)L_ * 3072 * 2;
constexpr size_t WS_PG = WS_PC + (size_t)L_ * 3072 * 2;
constexpr size_t WS_PLR = WS_PG + (size_t)L_ * 6144 * 2;
constexpr size_t WS_AA = WS_PLR + (size_t)L_ * 256 * 2;
constexpr size_t WS_ZT0 = WS_AA + (size_t)L_ * 512 * 2;
constexpr size_t WS_ZT1 = WS_ZT0 + (size_t)L_ * 512 * 2;
constexpr size_t WS_Z2T = WS_ZT1 + (size_t)L_ * 512 * 2;
constexpr size_t WS_G1T = WS_Z2T + (size_t)L_ * 512 * 2;
constexpr size_t WS_G2T = WS_G1T + (size_t)L_ * 512 * 2;
constexpr size_t WS_UPD = WS_G2T + (size_t)L_ * 512 * 2;
constexpr size_t WS_DEC = WS_UPD + (size_t)8 * 256 * 32768 * 2;
constexpr size_t WS_OC = WS_DEC + (size_t)8 * 256 * 128 * 4;
constexpr size_t WS_H3 = WS_OC + (size_t)L_ * 1024 * 2;
constexpr size_t WS_END = WS_H3 + (size_t)L_ * 64 * 2;

constexpr int LDS_BYTES = 147456;

struct Args { const float* in[29]; float* out; unsigned char* ws; int ph_lo, ph_hi; };

__device__ __forceinline__ void conv_w(const float* __restrict__ W, int K, int N, bf16_t* __restrict__ Wt, int nd64, int mode, float* tile) {
    const int tid = ltid(); const int nk4 = K >> 8; const int ntask = nk4 * nd64;
    for (int task = blockIdx.x; task < ntask; task += gridDim.x) {
        const int q = task / nk4, kt = task - q * nk4;
        int sc0, nvalid = 64;
        if (mode == 0) sc0 = q * 64;
        else if (mode == 1) { const int pn = q >> 2, sub = q & 3; sc0 = (sub >> 1) * F_ + pn * 128 + (sub & 1) * 64; }
        else { if (q < 96) sc0 = q * 64; else if (q < 192) sc0 = 6176 + (q - 96) * 64; else if (q == 192) { sc0 = 6144; nvalid = 32; } else { sc0 = 0; nvalid = 0; } }
        const int k0 = kt * 256;
        float4 v[8];
#pragma unroll
        for (int i = 0; i < 8; ++i) {
            const int r = (tid >> 4) + 32 * i, c4 = (tid & 15) * 4;
            v[i] = make_float4(0.f, 0.f, 0.f, 0.f);
            if (c4 < nvalid) v[i] = *(const float4*)(W + (size_t)(k0 + r) * N + sc0 + c4);
        }
#pragma unroll
        for (int i = 0; i < 8; ++i) {
            const int r = (tid >> 4) + 32 * i, c4 = (tid & 15) * 4;
            float* tp = tile + r * 65 + c4; tp[0] = v[i].x; tp[1] = v[i].y; tp[2] = v[i].z; tp[3] = v[i].w;
        }
        __syncthreads();
#pragma unroll
        for (int j = 0; j < 4; ++j) {
            const int n = tid >> 3, k8 = (tid & 7) * 8; const float* tp = tile + (j * 64 + k8) * 65 + n;
            u32x4 w; w.x = pk2(tp[0], tp[65]); w.y = pk2(tp[130], tp[195]); w.z = pk2(tp[260], tp[325]); w.w = pk2(tp[390], tp[455]);
            *(u32x4*)(Wt + (size_t)(q * 64 + n) * K + k0 + j * 64 + k8) = w;
        }
        __syncthreads();
    }
}

__device__ __forceinline__ void rms_rows_bf16(const float* __restrict__ src, const float* __restrict__ g, bf16_t* __restrict__ dst) {
    const int lane = ltid() & 63, wid = ltid() >> 6;
    for (int row = blockIdx.x * 8 + wid; row < L_; row += gridDim.x * 8) {
        const float* p = src + (size_t)row * D_; float4 v[8]; float ss = 0.f;
#pragma unroll
        for (int j = 0; j < 8; ++j) { v[j] = *(const float4*)(p + j * 256 + lane * 4); ss += v[j].x * v[j].x + v[j].y * v[j].y + v[j].z * v[j].z + v[j].w * v[j].w; }
#pragma unroll
        for (int o = 32; o >= 1; o >>= 1) ss += __shfl_xor(ss, o);
        const float sc = rsqrtf(ss * (1.f / 2048.f) + EPS_);
#pragma unroll
        for (int j = 0; j < 8; ++j) {
            const float4 gg = *(const float4*)(g + j * 256 + lane * 4);
            u32x2 w; w.x = pk2(v[j].x * sc * gg.x, v[j].y * sc * gg.y); w.y = pk2(v[j].z * sc * gg.z, v[j].w * sc * gg.w);
            *(u32x2*)(dst + (size_t)row * D_ + j * 256 + lane * 4) = w;
        }
    }
}
__device__ __forceinline__ void rms_rows_f32_inplace(float* __restrict__ buf, const float* __restrict__ g) {
    const int lane = ltid() & 63, wid = ltid() >> 6;
    for (int row = blockIdx.x * 8 + wid; row < L_; row += gridDim.x * 8) {
        float* p = buf + (size_t)row * D_; float4 v[8]; float ss = 0.f;
#pragma unroll
        for (int j = 0; j < 8; ++j) { v[j] = *(const float4*)(p + j * 256 + lane * 4); ss += v[j].x * v[j].x + v[j].y * v[j].y + v[j].z * v[j].z + v[j].w * v[j].w; }
#pragma unroll
        for (int o = 32; o >= 1; o >>= 1) ss += __shfl_xor(ss, o);
        const float sc = rsqrtf(ss * (1.f / 2048.f) + EPS_);
#pragma unroll
        for (int j = 0; j < 8; ++j) {
            const float4 gg = *(const float4*)(g + j * 256 + lane * 4);
            float4 o; o.x = v[j].x * sc * gg.x; o.y = v[j].y * sc * gg.y; o.z = v[j].z * sc * gg.z; o.w = v[j].w * sc * gg.w;
            *(float4*)(p + j * 256 + lane * 4) = o;
        }
    }
}

__device__ __forceinline__ void lr_proj(const bf16_t* __restrict__ XNr, const bf16_t* __restrict__ WCt, const float* __restrict__ biasp, bf16_t* __restrict__ PLR, unsigned char* sm) {
    const int tid = ltid(), lane = tid & 63, wid = tid >> 6, r = lane & 31, h = lane >> 5;
    float* part = (float*)sm;
    for (int base = blockIdx.x * 8; base < 2048; base += gridDim.x * 8) {
        f32x16 acc[2];
#pragma unroll
        for (int mi = 0; mi < 2; ++mi)
#pragma unroll
            for (int e = 0; e < 16; ++e) acc[mi][e] = 0.f;
        const bf16_t* a0 = XNr + (size_t)(base + (r & 7) + 2048 * (r >> 3)) * D_ + wid * 256 + 8 * h;
        const bf16_t* a1 = a0 + (size_t)4 * 2048 * D_;
        const bf16_t* b0 = WCt + (size_t)(12288 + r) * D_ + wid * 256 + 8 * h;
#pragma unroll 4
        for (int ks = 0; ks < 16; ++ks) {
            const bf16x8 bv = *(const bf16x8*)(b0 + ks * 16);
            const bf16x8 av0 = *(const bf16x8*)(a0 + ks * 16), av1 = *(const bf16x8*)(a1 + ks * 16);
            acc[0] = __builtin_amdgcn_mfma_f32_32x32x16_bf16(av0, bv, acc[0], 0, 0, 0);
            acc[1] = __builtin_amdgcn_mfma_f32_32x32x16_bf16(av1, bv, acc[1], 0, 0, 0);
        }
#pragma unroll
        for (int mi = 0; mi < 2; ++mi)
#pragma unroll
            for (int e = 0; e < 16; ++e) part[(wid * 64 + mi * 32 + (e & 3) + 8 * (e >> 2) + 4 * h) * 33 + r] = acc[mi][e];
        __syncthreads();
        {
            const int rr = tid >> 3, j0 = (tid & 7) * 4;
            float s[4] = {biasp[12288 + j0], biasp[12288 + j0 + 1], biasp[12288 + j0 + 2], biasp[12288 + j0 + 3]};
#pragma unroll
            for (int w = 0; w < 8; ++w)
#pragma unroll
                for (int j = 0; j < 4; ++j) s[j] += part[(w * 64 + rr) * 33 + j0 + j];
            u32x2 o; o.x = pk2(s[0], s[1]); o.y = pk2(s[2], s[3]);
            *(u32x2*)(PLR + (size_t)(base + (rr & 7) + 2048 * (rr >> 3)) * 256 + j0) = o;
        }
        __syncthreads();
    }
}

__device__ __forceinline__ void hyena_h3(const Args& a, int l, unsigned char* sm, _Float16* H3) {
    float* W1 = (float*)sm; float* W2 = W1 + 2112; float* W3 = W2 + 4096; float* B1 = W3 + 4096; float* B2 = B1 + 64; float* B3 = B2 + 64; float* FR = B3 + 64;
    float* bufA = FR + 64; float* bufB = bufA + 4160;
    const int tid = ltid();
    for (int i = tid; i < 2112; i += 512) W1[i] = a.in[9][(size_t)l * 2112 + i];
    for (int i = tid; i < 4096; i += 512) { W2[i] = a.in[11][(size_t)l * 4096 + i]; W3[i] = a.in[13][(size_t)l * 4096 + i]; }
    if (tid < 64) { B1[tid] = a.in[10][l * 64 + tid]; B2[tid] = a.in[12][l * 64 + tid]; B3[tid] = a.in[14][l * 64 + tid]; FR[tid] = a.in[16][l * 64 + tid]; }
    __syncthreads();
    const int pos = tid >> 3, q = tid & 7;
    for (int task = blockIdx.x; task < 256; task += gridDim.x) {
        const int t = task * 64 + pos; const float posf = (float)t;
        if (q == 0) bufA[pos * 65] = posf / 16383.f;
#pragma unroll
        for (int ii = 0; ii < 2; ++ii) {
            const int i = q + 8 * ii; const float band = 1e-4f + (float)i * ((15.f - 1e-4f) / 15.f);
            float rev = posf * band * (1.f / 16384.f); rev -= floorf(rev);
            bufA[pos * 65 + 1 + i] = __builtin_amdgcn_cosf(rev); bufA[pos * 65 + 17 + i] = -__builtin_amdgcn_sinf(rev);
        }
        __syncthreads();
        {   float acc[8];
#pragma unroll
            for (int jj = 0; jj < 8; ++jj) acc[jj] = B1[q * 8 + jj];
            for (int i = 0; i < 33; ++i) { const float x = bufA[pos * 65 + i];
#pragma unroll
                for (int jj = 0; jj < 8; ++jj) acc[jj] += x * W1[i * 64 + q * 8 + jj]; }
#pragma unroll
            for (int jj = 0; jj < 8; ++jj) bufB[pos * 65 + q * 8 + jj] = fsin_rad(FR[q * 8 + jj] * acc[jj]);
        }
        __syncthreads();
        {   float acc[8];
#pragma unroll
            for (int jj = 0; jj < 8; ++jj) acc[jj] = B2[q * 8 + jj];
            for (int i = 0; i < 64; ++i) { const float x = bufB[pos * 65 + i];
#pragma unroll
                for (int jj = 0; jj < 8; ++jj) acc[jj] += x * W2[i * 64 + q * 8 + jj]; }
#pragma unroll
            for (int jj = 0; jj < 8; ++jj) bufA[pos * 65 + q * 8 + jj] = fsin_rad(FR[q * 8 + jj] * acc[jj]);
        }
        __syncthreads();
        {   float acc[8];
#pragma unroll
            for (int jj = 0; jj < 8; ++jj) acc[jj] = B3[q * 8 + jj];
            for (int i = 0; i < 64; ++i) { const float x = bufA[pos * 65 + i];
#pragma unroll
                for (int jj = 0; jj < 8; ++jj) acc[jj] += x * W3[i * 64 + q * 8 + jj]; }
            typedef _Float16 h8 __attribute__((ext_vector_type(8)));
            h8 o;
#pragma unroll
            for (int jj = 0; jj < 8; ++jj) o[jj] = (_Float16)fsin_rad(FR[q * 8 + jj] * acc[jj]);
            *(h8*)(H3 + (size_t)t * 64 + q * 8) = o;
        }
        __syncthreads();
    }
}

__device__ __forceinline__ void branch_a_prep(const bf16_t* __restrict__ PA, const float* __restrict__ cw  , bf16_t* __restrict__ AA) {
#pragma unroll 2
    for (int idx = blockIdx.x * 512 + ltid(); idx < L_ * 64; idx += gridDim.x * 512) {
        const int t = idx >> 6, c8 = (idx & 63) * 8;
        const bf16_t* row = PA + (size_t)t * 3072 + c8;
        const u32x4 z4 = (u32x4){0u, 0u, 0u, 0u};
        const u32x4 xa0 = *(const u32x4*)row, ba0 = *(const u32x4*)(row + 512), ca0 = *(const u32x4*)(row + 1024);
        const u32x4 xam = t > 0 ? *(const u32x4*)(row - 3072) : z4, cam = t > 0 ? *(const u32x4*)(row - 3072 + 1024) : z4;
        const u32x4 xap = t < L_ - 1 ? *(const u32x4*)(row + 3072) : z4, cap = t < L_ - 1 ? *(const u32x4*)(row + 3072 + 1024) : z4;
        float x0[8], b0[8], c0[8], xm[8], cm[8], xp[8], cp[8];
        unpack8(xa0, x0); unpack8(ba0, b0); unpack8(ca0, c0); unpack8(xam, xm); unpack8(cam, cm); unpack8(xap, xp); unpack8(cap, cp);
        float w0[8], w1[8], w2[8];
        *(float4*)(w0) = *(const float4*)(cw + c8); *(float4*)(w0 + 4) = *(const float4*)(cw + c8 + 4);
        *(float4*)(w1) = *(const float4*)(cw + 512 + c8); *(float4*)(w1 + 4) = *(const float4*)(cw + 512 + c8 + 4);
        *(float4*)(w2) = *(const float4*)(cw + 1024 + c8); *(float4*)(w2 + 4) = *(const float4*)(cw + 1024 + c8 + 4);
        float o[8];
#pragma unroll
        for (int e = 0; e < 8; ++e) o[e] = b0[e] * (w0[e] * (cm[e] * xm[e]) + w1[e] * (c0[e] * x0[e]) + w2[e] * (cp[e] * xp[e]));
        u32x4 w; w.x = pk2(o[0], o[1]); w.y = pk2(o[2], o[3]); w.z = pk2(o[4], o[5]); w.w = pk2(o[6], o[7]);
        *(u32x4*)(AA + (size_t)t * 512 + c8) = w;
    }
}
__device__ __forceinline__ void hyena_prep(const bf16_t* __restrict__ PA, const float* __restrict__ cb  , bf16_t* ZT0, bf16_t* G1T, bf16_t* G2T) {
    const int c = ltid();
    for (int task = blockIdx.x; task < 768; task += gridDim.x) {
        const int arr = task >> 8, t0 = (task & 255) * 64;
        const float w0 = cb[(arr * 3 + 0) * 512 + c], w1 = cb[(arr * 3 + 1) * 512 + c], w2 = cb[(arr * 3 + 2) * 512 + c];
        const bf16_t* src = PA + 1536 + arr * 512 + c;
        bf16_t* dst = (arr == 0 ? ZT0 : (arr == 1 ? G1T : G2T)) + (size_t)c * L_ + t0;
        bf16_t raw[66];
#pragma unroll
        for (int k = 0; k < 66; ++k) { const int tt = t0 - 1 + k; raw[k] = (tt >= 0 && tt < L_) ? src[(size_t)tt * 3072] : (bf16_t)0; }
#pragma unroll
        for (int i8 = 0; i8 < 8; ++i8) {
            float o[8];
#pragma unroll
            for (int k = 0; k < 8; ++k) o[k] = w0 * bf2f(raw[i8 * 8 + k]) + w1 * bf2f(raw[i8 * 8 + k + 1]) + w2 * bf2f(raw[i8 * 8 + k + 2]);
            u32x4 w; w.x = pk2(o[0], o[1]); w.y = pk2(o[2], o[3]); w.z = pk2(o[4], o[5]); w.w = pk2(o[6], o[7]);
            *(u32x4*)(dst + i8 * 8) = w;
        }
    }
}

constexpr int G_GB = 0;
constexpr int G_W2 = 33024;
constexpr int G_BS = 41216;
constexpr int G_LR = 41728;
constexpr int G_TOT = 45824;
constexpr int G_QE = 47872;
constexpr int G_KE = 65280;
constexpr int G_VT = 82688;
constexpr int G_AA = 119552;
__device__ __forceinline__ void gla_b(const Args& a, int l, int hd, int dir, int t0, unsigned char* sm, const bf16_t* __restrict__ PLR) {
    float* Gb = (float*)(sm + G_GB); float* W2s = (float*)(sm + G_W2); float* Bs = (float*)(sm + G_BS); float* lrs = (float*)(sm + G_LR); float* tot = (float*)(sm + G_TOT);
    const int tid = ltid();
    const float* w2 = a.in[18] + ((size_t)(l * 2 + dir) * 16) * 512 + hd * 128;
    for (int i = tid; i < 2048; i += 512) W2s[i] = w2[(i >> 7) * 512 + (i & 127)];
    if (tid < 128) Bs[tid] = a.in[19][(l * 2 + dir) * 512 + hd * 128 + tid];
    for (int i = tid; i < 1024; i += 512) { const int j = i >> 4, r = i & 15; lrs[i] = bf2f(PLR[(size_t)(t0 + j) * 256 + dir * 16 + r]); }
    __syncthreads();
    const int d = tid & 127, q = tid >> 7;
    float run = 0.f;
    for (int k = 0; k < 16; ++k) {
        const int s = q * 16 + k, j = dir ? 63 - s : s;
        float x = Bs[d];
#pragma unroll
        for (int r = 0; r < 16; ++r) x += lrs[j * 16 + r] * W2s[r * 128 + d];
        const float g = (fminf(x, 0.f) - __logf(1.f + __expf(-fabsf(x)))) * (1.f / 16.f);
        run += g; Gb[j * 129 + d] = run;
    }
    tot[q * 128 + d] = run;
    __syncthreads();
    float off = 0.f;
    for (int qq = 0; qq < q; ++qq) off += tot[qq * 128 + d];
    if (q > 0) for (int k = 0; k < 16; ++k) { const int s = q * 16 + k, j = dir ? 63 - s : s; Gb[j * 129 + d] += off; }
    __syncthreads();
}
__device__ __forceinline__ void gla_load_vT(const bf16_t* __restrict__ PC, int hd, int t0, unsigned char* sm) {
    bf16_t* vT = (bf16_t*)(sm + G_VT);
    const int tid = ltid(), j = tid >> 3, v0 = (tid & 7) * 32;
    const bf16_t* vp = PC + (size_t)(t0 + j) * 3072 + 1024 + hd * 256 + v0;
#pragma unroll
    for (int i = 0; i < 4; ++i) {
        const u32x4 w = *(const u32x4*)(vp + i * 8);
        const int b = v0 + i * 8;
        vT[(b + 0) * 72 + j] = (bf16_t)(w.x & 0xffff); vT[(b + 1) * 72 + j] = (bf16_t)(w.x >> 16);
        vT[(b + 2) * 72 + j] = (bf16_t)(w.y & 0xffff); vT[(b + 3) * 72 + j] = (bf16_t)(w.y >> 16);
        vT[(b + 4) * 72 + j] = (bf16_t)(w.z & 0xffff); vT[(b + 5) * 72 + j] = (bf16_t)(w.z >> 16);
        vT[(b + 6) * 72 + j] = (bf16_t)(w.w & 0xffff); vT[(b + 7) * 72 + j] = (bf16_t)(w.w >> 16);
    }
}
__device__ __forceinline__ void gla_c1(const Args& a, int l, unsigned char* sm, const bf16_t* __restrict__ PC, const bf16_t* __restrict__ PLR, bf16_t* __restrict__ UPD, float* __restrict__ DEC) {
    const int tid = ltid(), lane = tid & 63, wid = tid >> 6, r = lane & 31, h = lane >> 5;
    float* Gb = (float*)(sm + G_GB); bf16_t* kdT = (bf16_t*)(sm + G_QE); bf16_t* vT = (bf16_t*)(sm + G_VT);
    for (int task = blockIdx.x; task < 2048; task += gridDim.x) {
        const int combo = task >> 8, n = task & 255, dir = combo >> 2, hd = combo & 3, t0 = n * 64;
        u32x4 kraw[2];
        { const bf16_t* kp = PC + (size_t)(t0 + (tid >> 3)) * 3072 + 512 + hd * 128 + (tid & 7) * 16; kraw[0] = *(const u32x4*)kp; kraw[1] = *(const u32x4*)(kp + 8); }
        gla_load_vT(PC, hd, t0, sm);
        gla_b(a, l, hd, dir, t0, sm, PLR);
        const int jb = dir ? 0 : 63;
        {
            const int j = tid >> 3, d0 = (tid & 7) * 16;
            float kv[16]; unpack8(kraw[0], kv); unpack8(kraw[1], kv + 8);
#pragma unroll
            for (int e = 0; e < 16; ++e) { const int d = d0 + e; kdT[d * 72 + j] = f2bf(kv[e] * __expf(Gb[jb * 129 + d] - Gb[j * 129 + d])); }
        }
        __syncthreads();
        f32x16 acc[4];
#pragma unroll
        for (int nt = 0; nt < 4; ++nt)
#pragma unroll
            for (int e = 0; e < 16; ++e) acc[nt][e] = 0.f;
#pragma unroll
        for (int ks = 0; ks < 4; ++ks) {
            const bf16x8 av = *(const bf16x8*)(vT + (32 * wid + r) * 72 + ks * 16 + 8 * h);
#pragma unroll
            for (int nt = 0; nt < 4; ++nt) { const bf16x8 bv = *(const bf16x8*)(kdT + (32 * nt + r) * 72 + ks * 16 + 8 * h); acc[nt] = __builtin_amdgcn_mfma_f32_32x32x16_bf16(av, bv, acc[nt], 0, 0, 0); }
        }
        bf16_t* up = UPD + ((size_t)(combo * 256 + n)) * 32768;
#pragma unroll
        for (int nt = 0; nt < 4; ++nt)
#pragma unroll
            for (int e = 0; e < 16; ++e) { const int dv = 32 * wid + (e & 3) + 8 * (e >> 2) + 4 * h, dk = 32 * nt + r; up[dv * 128 + dk] = f2bf(acc[nt][e]); }
        if (tid < 128) DEC[(size_t)(combo * 256 + n) * 128 + tid] = __expf(Gb[jb * 129 + tid]);
        __syncthreads();
    }
}
__device__ __forceinline__ void gla_scan(bf16_t* __restrict__ UPD, const float* __restrict__ DEC) {
    for (int idx = blockIdx.x * 512 + ltid(); idx < 131072; idx += gridDim.x * 512) {
        const int combo = idx >> 14, rem = idx & 16383, dv = rem >> 6, dk = (rem & 63) * 2, dir = combo >> 2;
        unsigned* up = (unsigned*)(UPD + (size_t)combo * 256 * 32768 + dv * 128 + dk);
        const float* dp = DEC + (size_t)combo * 256 * 128 + dk;
        float s0 = 0.f, s1 = 0.f;
        unsigned uv[8], un[8]; float2 dc[8], dn[8];
#pragma unroll
        for (int k = 0; k < 8; ++k) { const int n = dir ? 255 - k : k; uv[k] = up[(size_t)n * 16384]; dc[k] = *(const float2*)(dp + n * 128); }
        for (int nb = 0; nb < 256; nb += 8) {
            if (nb + 8 < 256) {
#pragma unroll
                for (int k = 0; k < 8; ++k) { const int n = dir ? 255 - (nb + 8 + k) : nb + 8 + k; un[k] = up[(size_t)n * 16384]; dn[k] = *(const float2*)(dp + n * 128); }
            }
#pragma unroll
            for (int k = 0; k < 8; ++k) { const int n = dir ? 255 - (nb + k) : nb + k; up[(size_t)n * 16384] = pk2(s0, s1); s0 = dc[k].x * s0 + bflo(uv[k]); s1 = dc[k].y * s1 + bfhi(uv[k]); }
#pragma unroll
            for (int k = 0; k < 8; ++k) { uv[k] = un[k]; dc[k] = dn[k]; }
        }
    }
}
__device__ __forceinline__ void gla_c3(const Args& a, int l, unsigned char* sm, const bf16_t* __restrict__ PC, const bf16_t* __restrict__ PLR, const bf16_t* __restrict__ UPD, bf16_t* __restrict__ OC) {
    const int tid = ltid(), lane = tid & 63, wid = tid >> 6, r = lane & 31, h = lane >> 5;
    float* Gb = (float*)(sm + G_GB); bf16_t* qeL = (bf16_t*)(sm + G_QE); bf16_t* keL = (bf16_t*)(sm + G_KE); bf16_t* vT = (bf16_t*)(sm + G_VT); bf16_t* Aa = (bf16_t*)(sm + G_AA);
    const float* gn = a.in[20] + l * 256;
    for (int task = blockIdx.x; task < 1024; task += gridDim.x) {
        const int hd = task >> 8, n = task & 255, t0 = n * 64;
        gla_load_vT(PC, hd, t0, sm);
        f32x16 accO[2];
#pragma unroll
        for (int mi = 0; mi < 2; ++mi)
#pragma unroll
            for (int e = 0; e < 16; ++e) accO[mi][e] = 0.f;
        for (int dir = 0; dir < 2; ++dir) {
            const bf16_t* Sg = UPD + ((size_t)((dir * 4 + hd) * 256 + n)) * 32768;
            bf16x8 sfr[8];
#pragma unroll
            for (int ks = 0; ks < 8; ++ks) sfr[ks] = *(const bf16x8*)(Sg + (32 * wid + r) * 128 + ks * 16 + 8 * h);
            u32x4 qraw[2], kraw[2];
            { const bf16_t* qp = PC + (size_t)(t0 + (tid >> 3)) * 3072 + hd * 128 + (tid & 7) * 16;
              qraw[0] = *(const u32x4*)qp; qraw[1] = *(const u32x4*)(qp + 8); kraw[0] = *(const u32x4*)(qp + 512); kraw[1] = *(const u32x4*)(qp + 520); }
            gla_b(a, l, hd, dir, t0, sm, PLR);
            {
                const int j = tid >> 3, d0 = (tid & 7) * 16;
                float qv[16], kv[16];
                unpack8(qraw[0], qv); unpack8(qraw[1], qv + 8);
                unpack8(kraw[0], kv); unpack8(kraw[1], kv + 8);
                float qo[16], ko[16];
#pragma unroll
                for (int e = 0; e < 16; ++e) { const float b = Gb[j * 129 + d0 + e]; qo[e] = qv[e] * 0.08838834764831845f * __expf(b); ko[e] = kv[e] * __expf(-b); }
                u32x4 w;
                w.x = pk2(qo[0], qo[1]); w.y = pk2(qo[2], qo[3]); w.z = pk2(qo[4], qo[5]); w.w = pk2(qo[6], qo[7]); *(u32x4*)(qeL + j * 136 + d0) = w;
                w.x = pk2(qo[8], qo[9]); w.y = pk2(qo[10], qo[11]); w.z = pk2(qo[12], qo[13]); w.w = pk2(qo[14], qo[15]); *(u32x4*)(qeL + j * 136 + d0 + 8) = w;
                w.x = pk2(ko[0], ko[1]); w.y = pk2(ko[2], ko[3]); w.z = pk2(ko[4], ko[5]); w.w = pk2(ko[6], ko[7]); *(u32x4*)(keL + j * 136 + d0) = w;
                w.x = pk2(ko[8], ko[9]); w.y = pk2(ko[10], ko[11]); w.z = pk2(ko[12], ko[13]); w.w = pk2(ko[14], ko[15]); *(u32x4*)(keL + j * 136 + d0 + 8) = w;
            }
            __syncthreads();
            if (wid < 4) {
                const int mi = wid >> 1, ni = wid & 1;
                f32x16 s;
#pragma unroll
                for (int e = 0; e < 16; ++e) s[e] = 0.f;
#pragma unroll
                for (int ks = 0; ks < 8; ++ks) {
                    const bf16x8 av = *(const bf16x8*)(qeL + (32 * mi + r) * 136 + ks * 16 + 8 * h);
                    const bf16x8 bv = *(const bf16x8*)(keL + (32 * ni + r) * 136 + ks * 16 + 8 * h);
                    s = __builtin_amdgcn_mfma_f32_32x32x16_bf16(av, bv, s, 0, 0, 0);
                }
#pragma unroll
                for (int e = 0; e < 16; ++e) { const int i = 32 * mi + (e & 3) + 8 * (e >> 2) + 4 * h, j = 32 * ni + r; const bool keep = dir ? (j >= i) : (j <= i); Aa[i * 72 + j] = f2bf(keep ? s[e] : 0.f); }
            }
            __syncthreads();
#pragma unroll
            for (int mi = 0; mi < 2; ++mi) {
#pragma unroll
                for (int ks = 0; ks < 4; ++ks) {
                    const bf16x8 av = *(const bf16x8*)(Aa + (32 * mi + r) * 72 + ks * 16 + 8 * h);
                    const bf16x8 bv = *(const bf16x8*)(vT + (32 * wid + r) * 72 + ks * 16 + 8 * h);
                    accO[mi] = __builtin_amdgcn_mfma_f32_32x32x16_bf16(av, bv, accO[mi], 0, 0, 0);
                }
#pragma unroll
                for (int ks = 0; ks < 8; ++ks) {
                    const bf16x8 av = *(const bf16x8*)(qeL + (32 * mi + r) * 136 + ks * 16 + 8 * h);
                    accO[mi] = __builtin_amdgcn_mfma_f32_32x32x16_bf16(av, sfr[ks], accO[mi], 0, 0, 0);
                }
            }
            __syncthreads();
        }
        float* Of = (float*)sm;
#pragma unroll
        for (int mi = 0; mi < 2; ++mi)
#pragma unroll
            for (int e = 0; e < 16; ++e) { const int i = 32 * mi + (e & 3) + 8 * (e >> 2) + 4 * h; Of[i * 260 + 32 * wid + r] = accO[mi][e]; }
        __syncthreads();
        bf16_t rgv[8][4];
#pragma unroll
        for (int rr = 0; rr < 8; ++rr)
#pragma unroll
            for (int q = 0; q < 4; ++q) rgv[rr][q] = PC[(size_t)(t0 + 8 * wid + rr) * 3072 + 2048 + hd * 256 + lane + 64 * q];
#pragma unroll
        for (int rr = 0; rr < 8; ++rr) {
            const int i = 8 * wid + rr, t = t0 + i;
            float v[4]; float ss = 0.f;
#pragma unroll
            for (int q = 0; q < 4; ++q) { v[q] = Of[i * 260 + lane + 64 * q]; ss += v[q] * v[q]; }
#pragma unroll
            for (int o = 32; o >= 1; o >>= 1) ss += __shfl_xor(ss, o);
            const float sc = rsqrtf(ss * (1.f / 256.f) + EPS_);
#pragma unroll
            for (int q = 0; q < 4; ++q) {
                const int col = lane + 64 * q;
                const float rg = bf2f(rgv[rr][q]);
                OC[(size_t)t * 1024 + hd * 256 + col] = f2bf(v[q] * sc * gn[col] * siluf_(rg));
            }
        }
        __syncthreads();
    }
}

constexpr int C_K = 0;
constexpr int C_Z = 65536;
constexpr int C_W = 98304;
constexpr int C_RED = 98816;
__device__ __forceinline__ void conv_build_filter(const Args& a, int l, int o, int c, unsigned char* sm, const _Float16* __restrict__ H3) {
    bf16_t* Kl = (bf16_t*)(sm + C_K); float* wl = (float*)(sm + C_W); float* red = (float*)(sm + C_RED);
    const int tid = ltid(), lane = tid & 63, wid = tid >> 6;
    const float* wo = a.in[15] + (size_t)l * 64 * 2048;
    if (tid < 128) wl[tid] = wo[(size_t)(tid & 63) * 2048 + o * 1024 + (tid >> 6) * 512 + c];
    if (tid == 0) Kl[0] = 0;
    __syncthreads();
    const float da = -3.0701134573253944f, db = -15.350567286626972f;
    const float adelta = fabsf(da + (float)c * ((db - da) / 511.f));
    float sf = 0.f, sb = 0.f;
    typedef _Float16 h8 __attribute__((ext_vector_type(8)));
    for (int i = 0; i < 32; ++i) {
        const int t = tid + 512 * i;
        const h8* hp = (const h8*)(H3 + (size_t)t * 64);
        float f = 0.f, b = 0.f;
#pragma unroll
        for (int k8 = 0; k8 < 8; ++k8) { const h8 hv = hp[k8];
#pragma unroll
            for (int e = 0; e < 8; ++e) { const float x = (float)hv[e]; f += x * wl[k8 * 8 + e]; b += x * wl[64 + k8 * 8 + e]; } }
        const float dec = __expf(-((float)t / 16383.f) * adelta);
        f *= dec; b *= dec; sf += fabsf(f); sb += fabsf(b);
        Kl[L_ + t] = f2bf(f);
        if (t > 0) Kl[L_ - t] = f2bf(b);
    }
#pragma unroll
    for (int ofs = 32; ofs >= 1; ofs >>= 1) { sf += __shfl_xor(sf, ofs); sb += __shfl_xor(sb, ofs); }
    if (lane == 0) { red[wid] = sf; red[8 + wid] = sb; }
    __syncthreads();
    float tf = 0.f, tb = 0.f;
#pragma unroll
    for (int w = 0; w < 8; ++w) { tf += red[w]; tb += red[8 + w]; }
    const float invf = 1.f / (tf + EPS_), invb = 1.f / (tb + EPS_);
    for (int x = tid; x < 32768; x += 512) { const float v = bf2f(Kl[x]); Kl[x] = f2bf(v * (x >= L_ ? invf : invb)); }
    __syncthreads();
}
__device__ __forceinline__ void hyena_conv_scalar(const Args& a, int l, int o, unsigned char* sm, const _Float16* __restrict__ H3,
                                                  const bf16_t* __restrict__ ZinT, const bf16_t* __restrict__ GT, bf16_t* __restrict__ OutT) {
    bf16_t* Kl = (bf16_t*)(sm + C_K); bf16_t* zl = (bf16_t*)(sm + C_Z);
    const int tid = ltid();
    for (int c = blockIdx.x; c < 512; c += gridDim.x) {
        conv_build_filter(a, l, o, c, sm, H3);
        for (int i = tid; i < 2048; i += 512) *(u32x4*)(zl + i * 8) = *(const u32x4*)(ZinT + (size_t)c * L_ + i * 8);
        __syncthreads();
        float acc[32];
#pragma unroll
        for (int j = 0; j < 32; ++j) acc[j] = 0.f;
        const bf16_t* kb = Kl + L_ + tid;
        for (int s = 0; s < L_; ++s) {
            const float zs = bf2f(zl[s]);
#pragma unroll
            for (int j = 0; j < 32; ++j) acc[j] += bf2f(kb[512 * j - s]) * zs;
        }
        const float skip = a.in[17][(l * 2 + o) * 512 + c];
#pragma unroll
        for (int j = 0; j < 32; ++j) {
            const int t = tid + 512 * j;
            const float zp = bf2f(zl[t]), gt = bf2f(GT[(size_t)c * L_ + t]);
            OutT[(size_t)c * L_ + t] = f2bf(gt * (acc[j] + skip * zp));
        }
        __syncthreads();
    }
}
typedef _Float16 h8_t __attribute__((ext_vector_type(8)));
__device__ __forceinline__ void hyena_filtgen(const Args& a, int l, int o, const _Float16* __restrict__ H3, bf16_t* __restrict__ FILT, u64_t* __restrict__ FSUM) {
    const int tid = ltid(), lane = tid & 63, wid = tid >> 6, r = lane & 31, h = lane >> 5;
    for (int task = blockIdx.x; task < 256; task += gridDim.x) {
        const int cg = task >> 3, part = task & 7;
        const float* wo = a.in[15] + (size_t)l * 64 * 2048 + o * 1024 + cg * 32 + r;
        h8_t wa[4];
#pragma unroll
        for (int ks = 0; ks < 4; ++ks)
#pragma unroll
            for (int e = 0; e < 8; ++e) wa[ks][e] = (_Float16)wo[(size_t)(ks * 16 + 8 * h + e) * 2048];
        const float da = -3.0701134573253944f, db = -15.350567286626972f;
        float adl[16], sabs[16];
#pragma unroll
        for (int e = 0; e < 16; ++e) { const int c = (cg * 32 + (e & 3) + 8 * (e >> 2) + 4 * h) & 511; adl[e] = fabsf(da + (float)c * ((db - da) / 511.f)) * (1.f / 16383.f); sabs[e] = 0.f; }
#pragma unroll 1
        for (int qt = 0; qt < 4; ++qt) {
            h8_t hb[2][4];
#pragma unroll
            for (int i = 0; i < 2; ++i) { const _Float16* hp = H3 + (size_t)(part * 2048 + (wid * 8 + qt * 2 + i) * 32 + r) * 64 + 8 * h;
#pragma unroll
                for (int ks = 0; ks < 4; ++ks) hb[i][ks] = *(const h8_t*)(hp + ks * 16); }
#pragma unroll
            for (int i = 0; i < 2; ++i) {
                f32x16 d;
#pragma unroll
                for (int e = 0; e < 16; ++e) d[e] = 0.f;
#pragma unroll
                for (int ks = 0; ks < 4; ++ks) d = __builtin_amdgcn_mfma_f32_32x32x16_f16(wa[ks], hb[i][ks], d, 0, 0, 0);
                const int t = part * 2048 + (wid * 8 + qt * 2 + i) * 32 + r; const float tf = (float)t;
#pragma unroll
                for (int e = 0; e < 16; ++e) {
                    const float v = d[e] * __expf(-tf * adl[e]);
                    sabs[e] += fabsf(v);
                    FILT[(size_t)(cg * 32 + (e & 3) + 8 * (e >> 2) + 4 * h) * L_ + t] = f2bf(v);
                }
            }
        }
#pragma unroll
        for (int e = 0; e < 16; ++e) {
            float s = sabs[e];
#pragma unroll
            for (int ofs = 16; ofs >= 1; ofs >>= 1) s += __shfl_xor(s, ofs);
            if (r == 0) atomicAdd(FSUM + cg * 32 + (e & 3) + 8 * (e >> 2) + 4 * h, (u64_t)(s * FS_FIX + 0.5f));
        }
    }
}
constexpr int M_PAD = 4096;
constexpr int M_ZN = L_ + 2 * M_PAD + 256;
constexpr int M_K = 0;
constexpr int M_Z = 66560;
constexpr int M_W = 119808;
constexpr int M_RED = 120320;
__device__ __forceinline__ int zpad(int idx) { return idx + ((idx >> 7) << 3); }
__device__ __forceinline__ bf16x8 ld_kfrag(const unsigned* kd, int x0, unsigned sh) {
    const int dw = x0 >> 1;
    const unsigned d0 = kd[dw], d1 = kd[dw + 1], d2 = kd[dw + 2], d3 = kd[dw + 3], d4 = kd[dw + 4];
    u32x4 o;
    o.x = __builtin_amdgcn_alignbit(d1, d0, sh); o.y = __builtin_amdgcn_alignbit(d2, d1, sh); o.z = __builtin_amdgcn_alignbit(d3, d2, sh); o.w = __builtin_amdgcn_alignbit(d4, d3, sh);
    return __builtin_bit_cast(bf16x8, o);
}
__device__ __forceinline__ unsigned swap16(unsigned w) { return (w >> 16) | (w << 16); }
__device__ __forceinline__ void hyena_conv_mfma(const Args& a, int l, int o, unsigned char* sm, const bf16_t* __restrict__ FILT, const u64_t* __restrict__ FSUM,
                                                const bf16_t* __restrict__ ZinT, const bf16_t* __restrict__ GT, bf16_t* __restrict__ OutT) {
    bf16_t* Kl = (bf16_t*)(sm + M_K); bf16_t* zp = (bf16_t*)(sm + M_Z);
    const int tid = ltid(), lane = tid & 63, wid = tid >> 6, r = lane & 31, h = lane >> 5, wk = wid >> 2, wn = wid & 3;
    for (int c = blockIdx.x; c < 512; c += gridDim.x) {
        {
            if (tid < 256) ((unsigned*)(sm + 65536))[tid] = 0u;
            if (tid == 0) Kl[0] = 0;
            const float invf = 1.f / ((float)FSUM[c] * (1.f / FS_FIX) + EPS_), invb = 1.f / ((float)FSUM[512 + c] * (1.f / FS_FIX) + EPS_);
            u32x4 fv[4];
#pragma unroll
            for (int j = 0; j < 4; ++j) fv[j] = *(const u32x4*)(FILT + (size_t)c * L_ + (tid + 512 * j) * 8);
#pragma unroll
            for (int j = 0; j < 4; ++j) {
                const int t8 = (tid + 512 * j) * 8;
                float x[8]; unpack8(fv[j], x);
                u32x4 w; w.x = pk2(x[0] * invf, x[1] * invf); w.y = pk2(x[2] * invf, x[3] * invf); w.z = pk2(x[4] * invf, x[5] * invf); w.w = pk2(x[6] * invf, x[7] * invf);
                *(u32x4*)(Kl + L_ + t8) = w;
            }
#pragma unroll
            for (int j = 0; j < 4; ++j) fv[j] = *(const u32x4*)(FILT + (size_t)(512 + c) * L_ + (tid + 512 * j) * 8);
#pragma unroll
            for (int j = 0; j < 4; ++j) {
                const int t8 = (tid + 512 * j) * 8;
                float x[8]; unpack8(fv[j], x);
#pragma unroll
                for (int e = 0; e < 8; ++e) if (t8 + e > 0) Kl[L_ - t8 - e] = f2bf(x[e] * invb);
            }
        }
        {
            u32x4 zv[7];
#pragma unroll
            for (int it = 0; it < 7; ++it) {
                const int idx0 = (tid + 512 * it) * 8; zv[it] = (u32x4){0u, 0u, 0u, 0u};
                if (idx0 >= M_PAD && idx0 < M_PAD + L_) zv[it] = *(const u32x4*)(ZinT + (size_t)c * L_ + (L_ + M_PAD - 8 - idx0));
            }
#pragma unroll
            for (int it = 0; it < 7; ++it) {
                const int idx0 = (tid + 512 * it) * 8;
                if (idx0 < M_ZN) { u32x4 w; w.x = swap16(zv[it].w); w.y = swap16(zv[it].z); w.z = swap16(zv[it].y); w.w = swap16(zv[it].x); *(u32x4*)(zp + zpad(idx0)) = w; }
            }
        }
        __syncthreads();
        const unsigned* kd = (const unsigned*)Kl;
        const int r16 = lane & 15, kg = lane >> 4;
        const int n0 = 32 * wn, sb0 = 4 * n0 + 320 * wk;
        const unsigned sh = ((1 + r16) & 1) * 16;
        const int xb = 1 + 8 * kg + r16 + 32 * sb0;
        const int zi0 = M_PAD - (n0 + r16) * 128 + 8 * kg + 32 * sb0;
        f32x4 acc[8][2];
#pragma unroll
        for (int q = 0; q < 8; ++q)
#pragma unroll
            for (int cc = 0; cc < 2; ++cc) acc[q][cc] = (f32x4){0.f, 0.f, 0.f, 0.f};
        {
        bf16x8 R[10];
#pragma unroll
        for (int m = 0; m < 6; ++m) R[m] = ld_kfrag(kd, xb + 16 * m, sh);
        unsigned ra[5], rb[5];
        { const int dwa = (xb + 16 * 6) >> 1, dwb = (xb + 16 * 7) >> 1;
#pragma unroll
          for (int e = 0; e < 5; ++e) { ra[e] = kd[dwa + e]; rb[e] = kd[dwb + e]; } }
        bf16x8 zr0 = *(const bf16x8*)(zp + zpad(zi0)), zr1 = *(const bf16x8*)(zp + zpad(zi0 - 16 * 128));
        for (int it = 0; it < 64; ++it) {
#pragma unroll
            for (int u = 0; u < 5; ++u) {
                const int j = it * 5 + u;
                { u32x4 oa, ob;
                  oa.x = __builtin_amdgcn_alignbit(ra[1], ra[0], sh); oa.y = __builtin_amdgcn_alignbit(ra[2], ra[1], sh); oa.z = __builtin_amdgcn_alignbit(ra[3], ra[2], sh); oa.w = __builtin_amdgcn_alignbit(ra[4], ra[3], sh);
                  ob.x = __builtin_amdgcn_alignbit(rb[1], rb[0], sh); ob.y = __builtin_amdgcn_alignbit(rb[2], rb[1], sh); ob.z = __builtin_amdgcn_alignbit(rb[3], rb[2], sh); ob.w = __builtin_amdgcn_alignbit(rb[4], rb[3], sh);
                  R[(2 * u + 6) % 10] = __builtin_bit_cast(bf16x8, oa); R[(2 * u + 7) % 10] = __builtin_bit_cast(bf16x8, ob); }
                const bf16x8 zb0 = zr0, zb1 = zr1;
                { const int dwa = (xb + 16 * (2 * j + 8)) >> 1, dwb = (xb + 16 * (2 * j + 9)) >> 1;
#pragma unroll
                  for (int e = 0; e < 5; ++e) { ra[e] = kd[dwa + e]; rb[e] = kd[dwb + e]; } }
                zr0 = *(const bf16x8*)(zp + zpad(zi0 + 32 * (j + 1))); zr1 = *(const bf16x8*)(zp + zpad(zi0 + 32 * (j + 1) - 16 * 128));
                __builtin_amdgcn_sched_barrier(0);
#pragma unroll
                for (int q = 0; q < 8; ++q) {
                    acc[q][0] = __builtin_amdgcn_mfma_f32_16x16x32_bf16(R[(2 * u + q) % 10], zb0, acc[q][0], 0, 0, 0);
                    acc[q][1] = __builtin_amdgcn_mfma_f32_16x16x32_bf16(R[(2 * u + q) % 10], zb1, acc[q][1], 0, 0, 0);
                }
                __builtin_amdgcn_sched_barrier(0);
            }
        }
        }
        __syncthreads();
        float* yb = (float*)(sm + M_K);
        if (wk == 0) {
#pragma unroll
            for (int q = 0; q < 8; ++q)
#pragma unroll
                for (int cc = 0; cc < 2; ++cc)
#pragma unroll
                    for (int e = 0; e < 4; ++e) yb[(n0 + 16 * cc + r16) * 129 + 16 * q + 4 * kg + e] = acc[q][cc][e];
        }
        __syncthreads();
        if (wk == 1) {
#pragma unroll
            for (int q = 0; q < 8; ++q)
#pragma unroll
                for (int cc = 0; cc < 2; ++cc)
#pragma unroll
                    for (int e = 0; e < 4; ++e) yb[(n0 + 16 * cc + r16) * 129 + 16 * q + 4 * kg + e] += acc[q][cc][e];
        }
        __syncthreads();
        const float skip = a.in[17][(l * 2 + o) * 512 + c];
        u32x4 gv4[4];
#pragma unroll
        for (int j = 0; j < 4; ++j) gv4[j] = *(const u32x4*)(GT + (size_t)c * L_ + (tid + 512 * j) * 8);
#pragma unroll
        for (int j = 0; j < 4; ++j) {
            const int t8 = (tid + 512 * j) * 8;
            const u32x4 zr = *(const u32x4*)(zp + zpad(L_ + M_PAD - 8 - t8));
            float zv[8], gg[8], ov[8];
            unpack8(zr, zv); unpack8(gv4[j], gg);
            const float* yp = yb + (t8 >> 7) * 129 + (t8 & 127);
#pragma unroll
            for (int e = 0; e < 8; ++e) ov[e] = gg[e] * (yp[e] + skip * zv[7 - e]);
            u32x4 w; w.x = pk2(ov[0], ov[1]); w.y = pk2(ov[2], ov[3]); w.z = pk2(ov[4], ov[5]); w.w = pk2(ov[6], ov[7]);
            *(u32x4*)(OutT + (size_t)c * L_ + t8) = w;
        }
        __syncthreads();
    }
}
__device__ __forceinline__ void transpose_z(const bf16_t* __restrict__ ZT, bf16_t* __restrict__ ZB, unsigned char* sm) {
    bf16_t* tile = (bf16_t*)sm;
    const int tid = ltid();
    for (int task4 = blockIdx.x; task4 < 512; task4 += gridDim.x) {
        const int c0 = (task4 >> 6) * 64, t0 = (task4 & 63) * 256;
        { const int cc = tid >> 3, t8 = (tid & 7) * 8;
          u32x4 v[4];
#pragma unroll
          for (int q = 0; q < 4; ++q) v[q] = *(const u32x4*)(ZT + (size_t)(c0 + cc) * L_ + t0 + q * 64 + t8);
#pragma unroll
          for (int q = 0; q < 4; ++q) *(u32x4*)(tile + q * 4608 + cc * 72 + t8) = v[q]; }
        __syncthreads();
        { const int tt = tid >> 3, c8 = (tid & 7) * 8;
#pragma unroll
          for (int q = 0; q < 4; ++q) {
              unsigned w[4];
#pragma unroll
              for (int k = 0; k < 4; ++k) w[k] = (unsigned)tile[q * 4608 + (c8 + 2 * k) * 72 + tt] | ((unsigned)tile[q * 4608 + (c8 + 2 * k + 1) * 72 + tt] << 16);
              *(u32x4*)(ZB + (size_t)(t0 + q * 64 + tt) * 512 + c0 + c8) = (u32x4){w[0], w[1], w[2], w[3]}; } }
        __syncthreads();
    }
}

#define XB_TMO      128
#define XB_XCNT(j)  (256  + 64 * (j))
#define XB_XSUB(j)  (1280 + 64 * (j))
#define XB_XGEN(j)  (2304 + 64 * (j))
#define XB_TOP      3328
#define XB_TOPGEN   3392
#define XCD_BAR_WORDS 3456
#define XB_SPIN_CAP (1u << 22)
__device__ __forceinline__ unsigned xb_ld(unsigned* p)              { return __hip_atomic_load(p, __ATOMIC_RELAXED, __HIP_MEMORY_SCOPE_AGENT); }
__device__ __forceinline__ unsigned xb_add(unsigned* p, unsigned v) { return __hip_atomic_fetch_add(p, v, __ATOMIC_RELAXED, __HIP_MEMORY_SCOPE_AGENT); }
__device__ __forceinline__ unsigned xb_xcc_id() { return (unsigned)__builtin_amdgcn_s_getreg((3 << 11) | 20) & 0xFu; }
#define XB_SPIN(cond, bar) do { unsigned _sp = 0; while (cond) { __builtin_amdgcn_s_sleep(1); \
    if ((++_sp & 255u) == 0u) { if (xb_ld(&(bar)[XB_TMO])) break; if (_sp > XB_SPIN_CAP) { atomicAdd(&(bar)[XB_TMO], 1u); break; } } } } while (0)
struct XcdBarrier { unsigned* bar; unsigned x; volatile PG8_LAS unsigned* st; };
__device__ __forceinline__ XcdBarrier xcd_barrier_post(unsigned* bar, volatile PG8_LAS unsigned* st) {
    XcdBarrier b; b.bar = bar; b.x = xb_xcc_id(); b.st = st;
    if (threadIdx.x == 0) (void)xb_add(&bar[XB_XCNT(b.x)], 1u);
    return b;
}
__device__ __forceinline__ void xcd_barrier_complete(unsigned* bar, unsigned x, unsigned& nloc, unsigned& nx) {
    const unsigned G = gridDim.x * gridDim.y * gridDim.z;
    unsigned sum, cnt, mine, sp = 0u;
    for (;;) {
        sum = 0u; cnt = 0u; mine = 0u;
#pragma unroll
        for (unsigned j = 0; j < 16; ++j) { const unsigned c = xb_ld(&bar[XB_XCNT(j)]); sum += c; cnt += (c > 0u) ? 1u : 0u; mine = (j == x) ? c : mine; }
        if (sum == G) break;
        __builtin_amdgcn_s_sleep(1);
        if ((++sp & 255u) == 0u) { if (xb_ld(&bar[XB_TMO])) break; if (sp > XB_SPIN_CAP) { atomicAdd(&bar[XB_TMO], 1u); break; } }
    }
    nloc = mine > 0u ? mine : 1u; nx = cnt > 0u ? cnt : 1u;
}
__device__ __forceinline__ void xcd_barrier(const XcdBarrier& b) {
    asm volatile("s_waitcnt vmcnt(0)" ::: "memory");
    __syncthreads();
    if (threadIdx.x == 0) {
        unsigned* bar = b.bar;
        __builtin_amdgcn_s_waitcnt(0);
        unsigned nloc = b.st[0], nx = b.st[1];
        if (nloc == 0u) { xcd_barrier_complete(bar, b.x, nloc, nx); b.st[0] = nloc; b.st[1] = nx; }
        const unsigned old = xb_add(&bar[XB_XSUB(b.x)], 1u);
        const unsigned gen = old / nloc;
        if (old + 1u == (gen + 1u) * nloc) {
            __builtin_amdgcn_fence(__ATOMIC_RELEASE, "agent");
            asm volatile("s_waitcnt vmcnt(0)" ::: "memory");
            const unsigned og = xb_add(&bar[XB_TOP], 1u);
            const unsigned tg = og / nx;
            if (og + 1u == (tg + 1u) * nx) xb_add(&bar[XB_TOPGEN], 1u);
            else XB_SPIN(xb_ld(&bar[XB_TOPGEN]) == tg, bar);
            __builtin_amdgcn_fence(__ATOMIC_ACQUIRE, "agent");
            xb_add(&bar[XB_XGEN(b.x)], 1u);
            asm volatile("s_waitcnt vmcnt(0)" ::: "memory");
        } else {
            XB_SPIN(xb_ld(&bar[XB_XGEN(b.x)]) == gen, bar);
            __builtin_amdgcn_fence(__ATOMIC_ACQUIRE, "agent");
            asm volatile("s_waitcnt vmcnt(0)" ::: "memory");
        }
    }
    __syncthreads();
}

__global__ void __launch_bounds__(512, 2) mega(Args a) {
    extern __shared__ __attribute__((aligned(16))) unsigned char smem[];
    cg::grid_group grid = cg::this_grid();
    PG8_LAS unsigned char* lds = (PG8_LAS unsigned char*)smem;
    const int G = gridDim.x, bid = blockIdx.x;
    volatile PG8_LAS unsigned* xst = (volatile PG8_LAS unsigned*)(lds + (LDS_BYTES - 16));
    if (threadIdx.x < 4) xst[threadIdx.x] = 0u;
    __syncthreads();
    const XcdBarrier xbar = xcd_barrier_post((unsigned*)(a.ws + WS_CTL), xst);
    for (int ph = a.ph_lo; ph < a.ph_hi && ph < 29; ++ph) {
        unsigned long long zoff = 0; asm volatile("" : "+s"(zoff));
        unsigned char* ws = a.ws + zoff;
        float* OUT = a.out;
        bf16_t* XN = (bf16_t*)(ws + WS_XN); bf16_t* PG = (bf16_t*)(ws + WS_PG);
        const int l = ph / 14, k = ph - l * 14;
        if (ph == 28) { rms_rows_f32_inplace(OUT, a.in[28]); }
        else for (int rep = 0; rep < ((ph == REPK) ? REPN : 1); ++rep) {
            if (rep) xcd_barrier(xbar);
            if (k == 0 || k == 3) {
                const int w0 = k == 0 ? 0 : 7, w1 = k == 0 ? 7 : 9;
                for (int wi = w0; wi < w1; ++wi) {
                    const float* W; int K, N, nd64, mode; size_t dof;
                    switch (wi) {
                        case 0: W = a.in[2] + (size_t)l * 2048 * 11264; K = 2048; N = 11264; dof = WS_WA; nd64 = 176; mode = 1; break;
                        case 1: W = a.in[3] + (size_t)l * 5632 * 2048; K = 5632; N = 2048; dof = WS_WB; nd64 = 32; mode = 0; break;
                        case 2: W = a.in[5] + (size_t)l * 2048 * 12320; K = 2048; N = 12320; dof = WS_WC; nd64 = 196; mode = 2; break;
                        case 3: W = a.in[21] + (size_t)l * 512 * 2048; K = 512; N = 2048; dof = WS_WBRA; nd64 = 32; mode = 0; break;
                        case 4: W = a.in[22] + (size_t)l * 512 * 2048; K = 512; N = 2048; dof = WS_WBRB; nd64 = 32; mode = 0; break;
                        case 5: W = a.in[23] + (size_t)l * 1024 * 2048; K = 1024; N = 2048; dof = WS_WBRC; nd64 = 32; mode = 0; break;
                        case 6: W = a.in[24] + (size_t)l * 2048 * 2048; K = 2048; N = 2048; dof = WS_WO; nd64 = 32; mode = 0; break;
                        case 7: W = a.in[26] + (size_t)l * 2048 * 11264; K = 2048; N = 11264; dof = WS_WA; nd64 = 176; mode = 1; break;
                        default: W = a.in[27] + (size_t)l * 5632 * 2048; K = 5632; N = 2048; dof = WS_WB; nd64 = 32; mode = 0; break;
                    }
                    conv_w(W, K, N, (bf16_t*)(ws + dof), nd64, mode, (float*)smem);
                }
            }
            if (k == 0) {
                float* BIASP = (float*)(ws + WS_BIAS);
                for (int i = bid * 512 + ltid(); i < NP_; i += G * 512) {
                    const float* b = a.in[6] + (size_t)l * 12320;
                    BIASP[i] = i < 6144 ? b[i] : (i < 12288 ? b[6176 + (i - 6144)] : (i < 12320 ? b[6144 + (i - 12288)] : 0.f));
                }
#ifndef NO_H3
                hyena_h3(a, l, smem, (_Float16*)(ws + WS_H3));
#endif
            }
            if (k == 0 || k == 3 || k == 11) {
                const float* src = (k == 0 && l == 0) ? a.in[0] : OUT;
                const float* gw = (k == 0 ? a.in[1] : (k == 3 ? a.in[4] : a.in[25])) + l * 2048;
                rms_rows_bf16(src, gw, XN);
                if (k == 3 && G == 256) {
                    asm volatile("s_waitcnt vmcnt(0)" ::: "memory"); __syncthreads();
                    lr_proj(XN, (const bf16_t*)(ws + WS_WC), (const float*)(ws + WS_BIAS), (bf16_t*)(ws + WS_PLR), smem);
                }
            }
            if (k == 5) {
                branch_a_prep((const bf16_t*)(ws + WS_PA), a.in[7] + l * 1536, (bf16_t*)(ws + WS_AA));
                hyena_prep((const bf16_t*)(ws + WS_PA), a.in[8] + l * 4608, (bf16_t*)(ws + WS_ZT0), (bf16_t*)(ws + WS_G1T), (bf16_t*)(ws + WS_G2T));
#ifndef NO_C1
                gla_c1(a, l, smem, (const bf16_t*)(ws + WS_PC), (const bf16_t*)(ws + WS_PLR), (bf16_t*)(ws + WS_UPD), (float*)(ws + WS_DEC));
                hyena_filtgen(a, l, 0, (const _Float16*)(ws + WS_H3), (bf16_t*)(ws + WS_WC), (u64_t*)(ws + WS_FSUM) + (l * 2 + 0) * 1024);
#endif
            }
            if (k == 6 && rep == 0) gla_scan((bf16_t*)(ws + WS_UPD), (const float*)(ws + WS_DEC));
            if (k == 6 || k == 7) {
                const int o = k - 6;
#ifndef NO_CONV
                if (o == 0) hyena_filtgen(a, l, 1, (const _Float16*)(ws + WS_H3), (bf16_t*)(ws + WS_PA), (u64_t*)(ws + WS_FSUM) + (l * 2 + 1) * 1024);
                hyena_conv_mfma(a, l, o, smem, (const bf16_t*)(ws + (o ? WS_PA : WS_WC)), (const u64_t*)(ws + WS_FSUM) + (l * 2 + o) * 1024, (const bf16_t*)(ws + (o ? WS_ZT1 : WS_ZT0)), (const bf16_t*)(ws + (o ? WS_G2T : WS_G1T)), (bf16_t*)(ws + (o ? WS_Z2T : WS_ZT1)));
#endif
            }
#ifndef NO_C3
            if (k == 7) gla_c3(a, l, smem, (const bf16_t*)(ws + WS_PC), (const bf16_t*)(ws + WS_PLR), (const bf16_t*)(ws + WS_UPD), (bf16_t*)(ws + WS_OC));
#endif
            if (k == 8) { transpose_z((const bf16_t*)(ws + WS_Z2T), (bf16_t*)(ws + WS_ZT0), smem); __syncthreads(); }
            const int ng = (k == 1 || k == 2 || k == 4 || k == 9 || k == 10 || k == 12 || k == 13) ? 1 : (k == 8 ? 2 : 0);
            for (int gi = 0; gi < ng; ++gi) {
                pg8::Gemm g; EpiAll E;
                g.M = L_;
                E.gu.H = (bf16_t*)(ws + WS_P);
                E.rs.res = OUT; E.rs.out = OUT; E.rs.scale = 1.f;
                E.in.PA = (bf16_t*)(ws + WS_PA); E.in.PC = (bf16_t*)(ws + WS_PC); E.in.PG = PG; E.in.PLR = (bf16_t*)(ws + WS_PLR); E.in.bias = (const float*)(ws + WS_BIAS);
                E.br.Mg = XN; E.br.gate = PG; E.br.first = 0;
                if (k == 1 || k == 12) { g.A = XN; g.Bt = (const bf16_t*)(ws + WS_WA); g.N = 11264; g.K = 2048; E.mode = 0; }
                else if (k == 2 || k == 13) { g.A = (const bf16_t*)(ws + WS_P); g.Bt = (const bf16_t*)(ws + WS_WB); g.N = 2048; g.K = 5632; E.mode = 1; E.rs.scale = 0.5f; if (ph == 2) E.rs.res = a.in[0]; }
                else if (k == 4) { g.A = XN; g.Bt = (const bf16_t*)(ws + WS_WC); g.N = (G == 256) ? 12288 : NP_; g.K = 2048; E.mode = 2; }
                else if (k == 8 && gi == 0) { g.A = (const bf16_t*)(ws + WS_AA); g.Bt = (const bf16_t*)(ws + WS_WBRA); g.N = 2048; g.K = 512; E.mode = 3; E.br.first = 1; }
                else if (k == 8) { g.A = (const bf16_t*)(ws + WS_OC); g.Bt = (const bf16_t*)(ws + WS_WBRC); g.N = 2048; g.K = 1024; E.mode = 3; E.br.gate = PG + 4096; }
                else if (k == 9) { g.A = (const bf16_t*)(ws + WS_ZT0); g.Bt = (const bf16_t*)(ws + WS_WBRB); g.N = 2048; g.K = 512; E.mode = 3; E.br.gate = PG + 2048; }
                else { g.A = XN; g.Bt = (const bf16_t*)(ws + WS_WO); g.N = 2048; g.K = 2048; E.mode = 1; }
                pg8::StaticOrder S; S.init(L_, g.N, G, bid);
#ifndef NO_GEMM
                pg8::gemm_phase<EpiAll, pg8::StaticOrder>(lds, g, S, E);
#endif
            }
        }
        if (ph + 1 < a.ph_hi && ph + 1 < 29) { if (ph == a.ph_lo) grid.sync(); else xcd_barrier(xbar); }
    }
}

extern "C" void kernel_launch(void* const* d_in, const int* in_sizes, int n_in, void* d_out, int out_size, void* d_ws, size_t ws_size, hipStream_t stream) {
    static int grid_blocks = 0;
    if (!grid_blocks) {
        int dev = 0, cus = 0, per_cu = 0;
        hipGetDevice(&dev);
        hipDeviceGetAttribute(&cus, hipDeviceAttributeMultiprocessorCount, dev);
        if (hipFuncSetAttribute((const void*)mega, hipFuncAttributeMaxDynamicSharedMemorySize, LDS_BYTES) != hipSuccess) fprintf(stderr, "hipFuncSetAttribute failed\n");
        hipOccupancyMaxActiveBlocksPerMultiprocessor(&per_cu, (const void*)mega, 512, LDS_BYTES);
        (void)hipGetLastError();
        if (per_cu < 1) per_cu = 1;
        if (per_cu > 1) per_cu = 1;
        grid_blocks = cus * per_cu;
        if (ws_size < WS_END) fprintf(stderr, "workspace too small: %zu < %zu\n", ws_size, (size_t)WS_END);
    }
    Args a{};
    for (int i = 0; i < 29; ++i) a.in[i] = (const float*)d_in[i];
    a.out = (float*)d_out; a.ws = (unsigned char*)d_ws;
    (void)hipMemsetAsync((unsigned char*)d_ws + WS_CTL, 0, 49152, stream);
#if COOP
    a.ph_lo = 0; a.ph_hi = 1000;
    void* args[] = {&a};
    hipError_t e = hipLaunchCooperativeKernel((const void*)mega, dim3(grid_blocks), dim3(512), args, LDS_BYTES, stream);
    if (e != hipSuccess) fprintf(stderr, "cooperative launch failed: %s (grid %d)\n", hipGetErrorString(e), grid_blocks);
#else
    for (int p = 0; p < 29; ++p) { a.ph_lo = p; a.ph_hi = p + 1; hipLaunchKernelGGL(mega, dim3(grid_blocks), dim3(512), LDS_BYTES, stream, a); }
#endif
}
```

```cpp
#include <hip/hip_runtime.h>
#include <hip/hip_cooperative_groups.h>
#include <cstdio>
namespace cg = cooperative_groups;

#define COOP 1
#define REPK -1
#define REPN 3
#define NREP_MAIN 1

typedef unsigned short bf16_t;
typedef short bf16x8 __attribute__((ext_vector_type(8)));
typedef float f32x4 __attribute__((ext_vector_type(4)));
typedef float f32x16 __attribute__((ext_vector_type(16)));
typedef unsigned u32x4 __attribute__((ext_vector_type(4)));
typedef unsigned u32x2 __attribute__((ext_vector_type(2)));
typedef unsigned long long u64_t;
constexpr float FS_FIX = 16777216.f;

constexpr int L_ = 16384, D_ = 2048, F_ = 5632, NP_ = 12544;
constexpr float EPS_ = 1e-5f;

__device__ __forceinline__ unsigned pk2(float lo, float hi) { unsigned r; asm volatile("v_cvt_pk_bf16_f32 %0, %1, %2" : "=v"(r) : "v"(lo), "v"(hi)); return r; }
__device__ __forceinline__ bf16_t f2bf(float f) { return (bf16_t)(pk2(f, 0.f) & 0xffffu); }
__device__ __forceinline__ float bf2f(bf16_t v) { return __uint_as_float(((unsigned)v) << 16); }
__device__ __forceinline__ float bflo(unsigned w) { return __uint_as_float(w << 16); }
__device__ __forceinline__ float bfhi(unsigned w) { return __uint_as_float(w & 0xffff0000u); }
__device__ __forceinline__ void unpack8(const u32x4 w, float* o) { o[0] = bflo(w.x); o[1] = bfhi(w.x); o[2] = bflo(w.y); o[3] = bfhi(w.y); o[4] = bflo(w.z); o[5] = bfhi(w.z); o[6] = bflo(w.w); o[7] = bfhi(w.w); }
__device__ __forceinline__ float sigmoidf_(float x) { return __builtin_amdgcn_rcpf(1.f + __expf(-x)); }
__device__ __forceinline__ float siluf_(float x) { return x * sigmoidf_(x); }
__device__ __forceinline__ float fsin_rad(float x) { float r = x * 0.15915494309189535f; r -= rintf(r); return __builtin_amdgcn_sinf(r); }

__device__ __forceinline__ int ltid() { int t = threadIdx.x; asm volatile("" : "+v"(t)); return t; }
namespace pg8 {
#define PG8_LAS __attribute__((address_space(3)))
constexpr int BM = 256, BK = 64, HALF = 128, HTB = HALF * BK * 2, STAGE_BYTES = 8 * HTB, NXCD = 8, WGM = 8;
__host__ __device__ __forceinline__ int lds_byte(int r, int c) { const int st = (r >> 4) * 2 + (c >> 5), rr = r & 15, cc = c & 31, ob = rr * 64 + cc * 2; return st * 1024 + (ob ^ (((ob >> 9) & 1) << 5)); }
__host__ __device__ __forceinline__ void stage_rc(int b, int& R, int& C) { const int st = b / 1024, sb = b % 1024, swz = sb ^ (((sb >> 9) & 1) << 5); R = (st >> 1) * 16 + swz / 64; C = (st & 1) * 32 + (swz % 64) / 2; }
__host__ __device__ __forceinline__ int perm32(int rho) { const int n = rho >> 4, i = rho & 15; return 8 * (i >> 2) + 4 * n + (i & 3); }
struct Unit { int pm, pn; };
struct Gemm { const bf16_t* A; const bf16_t* Bt; int M, N, K; };
struct StaticOrder {
    int nM, nN, nwg, G, c;
    __host__ __device__ void init(int M, int N, int G_, int c_) { nM = M / BM; nN = N / BM; nwg = nM * nN; G = G_; c = c_; }
    __host__ __device__ bool next(int i, Unit& u) const {
        const long Lx = (long)i * G + c; if (Lx >= nwg) return false;
        int wgid = (int)Lx; { const int q = nwg / NXCD, r = nwg % NXCD, xcd = wgid % NXCD, off = wgid / NXCD; wgid = (xcd < r ? xcd * (q + 1) : r * (q + 1) + (xcd - r) * q) + off; }
        const int wgm = (nN == 8) ? 4 : WGM;
        const int nig = wgm * nN, gid = wgid / nig, fm = gid * wgm, gsz = (nM - fm) < wgm ? (nM - fm) : wgm;
        u.pm = fm + ((wgid % nig) % gsz); u.pn = (wgid % nig) / gsz; return true;
    }
    __device__ __forceinline__ void a_ready(const Unit&) const {}
    __device__ __forceinline__ void done(const Unit&) const {}
};

template <class Epi, class Sched>
__device__ __forceinline__ void gemm_phase(PG8_LAS unsigned char* lds, const Gemm g, const Sched& S, const Epi& E) {
    int tid_ = threadIdx.x; asm volatile("" : "+v"(tid_));
    const int tid = tid_, wid = __builtin_amdgcn_readfirstlane(tid >> 6), lane = tid & 63, wr = wid >> 2, wc = wid & 3, fr = lane & 15, fq = lane >> 4;
    const int K = g.K, nt = K / BK;
    unsigned voffA[2], voffB[2];
#pragma unroll
    for (int i = 0; i < 2; ++i) { int R, C; stage_rc(tid * 16 + i * 8192, R, C); const int Rb = E.perm() ? ((R & ~31) + perm32(R & 31)) : R;
        voffA[i] = (unsigned)(R * K + C) * 2u; voffB[i] = (unsigned)(Rb * K + C) * 2u; }
    const size_t kstep = (size_t)(BK * 2);
    const size_t hstep = (size_t)HALF * K * 2;
    const size_t tstep = 2 * hstep;
    const unsigned ldsw = (unsigned)wid * 1024u;
    const int aoff = lds_byte(wr * 64 + fr, fq * 8), boff = lds_byte(wc * 32 + fr, fq * 8);
#define PG8_SA(b, h) (((b) * 2 + (h)) * HTB)
#define PG8_SB(b, h) ((4 + (b) * 2 + (h)) * HTB)
#define PG8_STAGE(bufoff, gbase, voff) do { _Pragma("unroll") for (int _i = 0; _i < 2; ++_i) \
        __builtin_amdgcn_global_load_lds((const unsigned*)((const char*)(gbase) + (voff)[_i]), (PG8_LAS unsigned*)(lds + (bufoff) + ldsw + _i * 8192), 16, 0, 0); } while (0)
#define PG8_LDA(dst, b, h) do { _Pragma("unroll") for (int m = 0; m < 4; ++m) _Pragma("unroll") for (int k = 0; k < 2; ++k) dst[m][k] = *(const PG8_LAS bf16x8*)(lds + PG8_SA(b, h) + aoff + m * 2048 + k * 1024); } while (0)
#define PG8_LDB(dst, b, h) do { _Pragma("unroll") for (int n = 0; n < 2; ++n) _Pragma("unroll") for (int k = 0; k < 2; ++k) dst[n][k] = *(const PG8_LAS bf16x8*)(lds + PG8_SB(b, h) + boff + n * 2048 + k * 1024); } while (0)
#define PG8_MMA(ai, bj, At, Bt) do { __builtin_amdgcn_s_setprio(1); _Pragma("unroll") for (int m = 0; m < 4; ++m) _Pragma("unroll") for (int n = 0; n < 2; ++n) _Pragma("unroll") for (int k = 0; k < 2; ++k) \
        acc[ai][bj][m][n] = __builtin_amdgcn_mfma_f32_16x16x32_bf16(Bt[n][k], At[m][k], acc[ai][bj][m][n], 0, 0, 0); __builtin_amdgcn_s_setprio(0); } while (0)
#define PG8_WAIT_V(n) asm volatile("s_waitcnt vmcnt(" #n ")" ::: "memory")
#define PG8_WAIT_L(n) asm volatile("s_waitcnt lgkmcnt(" #n ")" ::: "memory")
#define PG8_BAR __builtin_amdgcn_s_barrier()
#define PG8_SCHED __builtin_amdgcn_sched_barrier(0)
    Unit cur, nxt; int ui = 0;
    if (!S.next(0, cur)) return;
    f32x4 acc[2][2][4][2];
#pragma unroll
    for (int a = 0; a < 2; ++a)
#pragma unroll
        for (int b = 0; b < 2; ++b)
#pragma unroll
            for (int m = 0; m < 4; ++m)
#pragma unroll
                for (int n = 0; n < 2; ++n) acc[a][b][m][n] = (f32x4){0.f, 0.f, 0.f, 0.f};
    bf16x8 At[4][2], B0[2][2], B1[2][2];
    const char* cA = (const char*)g.A + (size_t)cur.pm * tstep; const char* cB = (const char*)g.Bt + (size_t)cur.pn * tstep;
    S.a_ready(cur);
    PG8_STAGE(PG8_SB(0, 0), cB, voffB); PG8_STAGE(PG8_SB(0, 1), cB + hstep, voffB); PG8_STAGE(PG8_SA(0, 0), cA, voffA); PG8_STAGE(PG8_SA(0, 1), cA + hstep, voffA);
    if (wr == 1) PG8_BAR;
    PG8_WAIT_V(2); PG8_BAR;
    PG8_STAGE(PG8_SB(1, 0), cB + kstep, voffB); PG8_STAGE(PG8_SA(1, 0), cA + kstep, voffA); PG8_STAGE(PG8_SB(1, 1), cB + hstep + kstep, voffB);
    PG8_WAIT_V(6); PG8_BAR;
    for (;;) {
        const bool has_next = S.next(ui + 1, nxt);
        const char* nA = has_next ? (const char*)g.A + (size_t)nxt.pm * tstep : cA; const char* nB = has_next ? (const char*)g.Bt + (size_t)nxt.pn * tstep : cB;
        for (int t = 0; t < nt; t += 2) {
            const bool last = (t == nt - 2);
            const char* a1 = cA + (size_t)(t + 1) * kstep;
            const char* a2 = last ? nA : cA + (size_t)(t + 2) * kstep; const char* b2 = last ? nB : cB + (size_t)(t + 2) * kstep;
            const char* a3 = a2 + kstep; const char* b3 = b2 + kstep;
            if (last && has_next) S.a_ready(nxt);
            PG8_LDB(B0, 0, 0); PG8_LDB(B1, 0, 1); PG8_SCHED; PG8_LDA(At, 0, 0); PG8_STAGE(PG8_SA(1, 1), a1 + hstep, voffA);
            PG8_WAIT_V(8); PG8_WAIT_L(0); PG8_BAR; PG8_MMA(0, 0, At, B0); PG8_MMA(0, 1, At, B1); PG8_BAR; PG8_SCHED;
            PG8_LDA(At, 0, 1); PG8_STAGE(PG8_SB(0, 0), b2, voffB); PG8_STAGE(PG8_SB(0, 1), b2 + hstep, voffB); PG8_STAGE(PG8_SA(0, 0), a2, voffA);
            PG8_WAIT_V(8); PG8_WAIT_L(0); PG8_BAR; PG8_MMA(1, 0, At, B0); PG8_MMA(1, 1, At, B1); PG8_BAR; PG8_SCHED;
            PG8_LDB(B0, 1, 0); PG8_LDB(B1, 1, 1); PG8_SCHED; PG8_LDA(At, 1, 0); PG8_STAGE(PG8_SA(0, 1), a2 + hstep, voffA);
            PG8_WAIT_V(8); PG8_WAIT_L(0); PG8_BAR; PG8_MMA(0, 0, At, B0); PG8_MMA(0, 1, At, B1); PG8_BAR; PG8_SCHED;
            PG8_LDA(At, 1, 1); PG8_STAGE(PG8_SB(1, 0), b3, voffB); PG8_STAGE(PG8_SB(1, 1), b3 + hstep, voffB); PG8_STAGE(PG8_SA(1, 0), a3, voffA);
            PG8_WAIT_V(8); PG8_WAIT_L(0); PG8_BAR; PG8_MMA(1, 0, At, B0); PG8_MMA(1, 1, At, B1); PG8_BAR; PG8_SCHED;
        }
        if (wr == 0) PG8_BAR;
        E(acc, cur, wr, wc, fr, fq); S.done(cur);
        if (!has_next) break;
#pragma unroll
        for (int a = 0; a < 2; ++a)
#pragma unroll
            for (int b = 0; b < 2; ++b)
#pragma unroll
                for (int m = 0; m < 4; ++m)
#pragma unroll
                    for (int n = 0; n < 2; ++n) acc[a][b][m][n] = (f32x4){0.f, 0.f, 0.f, 0.f};
        cur = nxt; cA = nA; cB = nB; ++ui;
        if (wr == 1) PG8_BAR;
    }
    PG8_WAIT_V(0);
    PG8_BAR;
#undef PG8_SA
#undef PG8_SB
#undef PG8_STAGE
#undef PG8_LDA
#undef PG8_LDB
#undef PG8_MMA
#undef PG8_WAIT_V
#undef PG8_WAIT_L
#undef PG8_BAR
#undef PG8_SCHED
}
}

struct EpiGU {
    static constexpr bool PERM = true, AFTER_DRAIN = false;
    bf16_t* H;
    __device__ __forceinline__ void operator()(const f32x4 (&acc)[2][2][4][2], const pg8::Unit& u, int wr, int wc, int fr, int fq) const {
        const int row0 = u.pm * 256 + wr * 64 + fr, col0 = u.pn * 128 + wc * 32 + 8 * fq;
#pragma unroll
        for (int ai = 0; ai < 2; ++ai)
#pragma unroll
            for (int m = 0; m < 4; ++m) {
                bf16_t* rowp = H + (size_t)(row0 + ai * 128 + m * 16) * F_ + col0;
                const f32x4 g0 = acc[ai][0][m][0], g1 = acc[ai][0][m][1], u0 = acc[ai][1][m][0], u1 = acc[ai][1][m][1];
                u32x4 w;
                w.x = pk2(siluf_(g0[0]) * u0[0], siluf_(g0[1]) * u0[1]); w.y = pk2(siluf_(g0[2]) * u0[2], siluf_(g0[3]) * u0[3]);
                w.z = pk2(siluf_(g1[0]) * u1[0], siluf_(g1[1]) * u1[1]); w.w = pk2(siluf_(g1[2]) * u1[2], siluf_(g1[3]) * u1[3]);
                *(u32x4*)rowp = w;
            }
    }
};
struct EpiRes {
    static constexpr bool PERM = false, AFTER_DRAIN = false;
    const float* res; float* out; float scale;
    __device__ __forceinline__ void operator()(const f32x4 (&acc)[2][2][4][2], const pg8::Unit& u, int wr, int wc, int fr, int fq) const {
        const int row0 = u.pm * 256 + wr * 64 + fr, col0 = u.pn * 256 + wc * 32 + 4 * fq;
        f32x4 cur[4], nxt[4];
        {   const size_t off = (size_t)row0 * D_ + col0;
#pragma unroll
            for (int j = 0; j < 4; ++j) cur[j] = *(const f32x4*)(res + off + (j >> 1) * 128 + (j & 1) * 16); }
#pragma unroll
        for (int g = 0; g < 8; ++g) {
            const int ai = g >> 2, m = g & 3;
            if (g < 7) { const int ai2 = (g + 1) >> 2, m2 = (g + 1) & 3; const size_t off2 = (size_t)(row0 + ai2 * 128 + m2 * 16) * D_ + col0;
#pragma unroll
                for (int j = 0; j < 4; ++j) nxt[j] = *(const f32x4*)(res + off2 + (j >> 1) * 128 + (j & 1) * 16); }
            const size_t off = (size_t)(row0 + ai * 128 + m * 16) * D_ + col0;
#pragma unroll
            for (int j = 0; j < 4; ++j) *(f32x4*)(out + off + (j >> 1) * 128 + (j & 1) * 16) = cur[j] + scale * acc[ai][j >> 1][m][j & 1];
#pragma unroll
            for (int j = 0; j < 4; ++j) cur[j] = nxt[j];
        }
    }
};
struct EpiIn {
    static constexpr bool PERM = true, AFTER_DRAIN = false;
    bf16_t *PA, *PC, *PG, *PLR; const float* bias;
    __device__ __forceinline__ void operator()(const f32x4 (&acc)[2][2][4][2], const pg8::Unit& u, int wr, int wc, int fr, int fq) const {
        bf16_t* base; int ld, ct;
        if (u.pn < 12) { base = PA; ld = 3072; ct = u.pn * 256; }
        else if (u.pn < 24) { base = PC; ld = 3072; ct = (u.pn - 12) * 256; }
        else if (u.pn < 48) { base = PG; ld = 6144; ct = (u.pn - 24) * 256; }
        else { base = PLR; ld = 256; ct = 0; }
        const int row0 = u.pm * 256 + wr * 64 + fr, cx = wc * 32 + 8 * fq;
        f32x4 bv[2][2];
#pragma unroll
        for (int bj = 0; bj < 2; ++bj)
#pragma unroll
            for (int n = 0; n < 2; ++n) bv[bj][n] = *(const f32x4*)(bias + u.pn * 256 + bj * 128 + cx + 4 * n);
#pragma unroll
        for (int ai = 0; ai < 2; ++ai)
#pragma unroll
            for (int m = 0; m < 4; ++m) {
                bf16_t* rowp = base + (size_t)(row0 + ai * 128 + m * 16) * ld + ct + cx;
#pragma unroll
                for (int bj = 0; bj < 2; ++bj) {
                    const f32x4 v0 = acc[ai][bj][m][0] + bv[bj][0], v1 = acc[ai][bj][m][1] + bv[bj][1];
                    u32x4 w; w.x = pk2(v0[0], v0[1]); w.y = pk2(v0[2], v0[3]); w.z = pk2(v1[0], v1[1]); w.w = pk2(v1[2], v1[3]);
                    *(u32x4*)(rowp + bj * 128) = w;
                }
            }
    }
};
struct EpiBr {
    static constexpr bool PERM = true, AFTER_DRAIN = false;
    bf16_t* Mg; const bf16_t* gate; int first;
    __device__ __forceinline__ void operator()(const f32x4 (&acc)[2][2][4][2], const pg8::Unit& u, int wr, int wc, int fr, int fq) const {
        const int row0 = u.pm * 256 + wr * 64 + fr, col0 = u.pn * 256 + wc * 32 + 8 * fq;
        const u32x4 z4 = (u32x4){0u, 0u, 0u, 0u};
        u32x4 gc[2], pc[2], gn[2], pn2[2];
#pragma unroll
        for (int bj = 0; bj < 2; ++bj) { gc[bj] = *(const u32x4*)(gate + (size_t)row0 * 6144 + col0 + bj * 128); pc[bj] = first ? z4 : *(const u32x4*)(Mg + (size_t)row0 * D_ + col0 + bj * 128); }
#pragma unroll
        for (int g = 0; g < 8; ++g) {
            const int ai = g >> 2, m = g & 3, row = row0 + ai * 128 + m * 16;
            if (g < 7) { const int row2 = row0 + ((g + 1) >> 2) * 128 + ((g + 1) & 3) * 16;
#pragma unroll
                for (int bj = 0; bj < 2; ++bj) { gn[bj] = *(const u32x4*)(gate + (size_t)row2 * 6144 + col0 + bj * 128); pn2[bj] = first ? z4 : *(const u32x4*)(Mg + (size_t)row2 * D_ + col0 + bj * 128); } }
#pragma unroll
            for (int bj = 0; bj < 2; ++bj) {
                float gv[8], pv[8]; unpack8(gc[bj], gv); unpack8(pc[bj], pv);
                const f32x4 a0 = acc[ai][bj][m][0], a1 = acc[ai][bj][m][1];
                u32x4 w;
                w.x = pk2(pv[0] + sigmoidf_(gv[0]) * a0[0], pv[1] + sigmoidf_(gv[1]) * a0[1]);
                w.y = pk2(pv[2] + sigmoidf_(gv[2]) * a0[2], pv[3] + sigmoidf_(gv[3]) * a0[3]);
                w.z = pk2(pv[4] + sigmoidf_(gv[4]) * a1[0], pv[5] + sigmoidf_(gv[5]) * a1[1]);
                w.w = pk2(pv[6] + sigmoidf_(gv[6]) * a1[2], pv[7] + sigmoidf_(gv[7]) * a1[3]);
                *(u32x4*)(Mg + (size_t)row * D_ + col0 + bj * 128) = w;
            }
#pragma unroll
            for (int bj = 0; bj < 2; ++bj) { gc[bj] = gn[bj]; pc[bj] = pn2[bj]; }
        }
    }
};
struct EpiAll {
    int mode;
    EpiGU gu; EpiRes rs; EpiIn in; EpiBr br;
    __device__ __forceinline__ bool perm() const { return mode != 1; }
    __device__ __forceinline__ void operator()(const f32x4 (&acc)[2][2][4][2], const pg8::Unit& u, int wr, int wc, int fr, int fq) const {
        if (mode == 0) gu(acc, u, wr, wc, fr, fq);
        else if (mode == 1) rs(acc, u, wr, wc, fr, fq);
        else if (mode == 2) in(acc, u, wr, wc, fr, fq);
        else br(acc, u, wr, wc, fr, fq);
    }
};

constexpr size_t WS_CTL = 0;
constexpr size_t WS_FSUM = 16384;
constexpr size_t WS_WA = 49152;
constexpr size_t WS_WB = WS_WA + (size_t)11264 * 2048 * 2;
constexpr size_t WS_WC = WS_WB + (size_t)2048 * 5632 * 2;
constexpr size_t WS_WBRA = WS_WC + (size_t)NP_ * 2048 * 2;
constexpr size_t WS_WBRB = WS_WBRA + (size_t)2048 * 512 * 2;
constexpr size_t WS_WBRC = WS_WBRB + (size_t)2048 * 512 * 2;
constexpr size_t WS_WO = WS_WBRC + (size_t)2048 * 1024 * 2;
constexpr size_t WS_BIAS = WS_WO + (size_t)2048 * 2048 * 2;
constexpr size_t WS_XN = WS_BIAS + 65536;
constexpr size_t WS_P = WS_XN + (size_t)L_ * D_ * 2;
constexpr size_t WS_PA = WS_P;
constexpr size_t WS_PC = WS_PA + (size_t)L_ * 3072 * 2;
constexpr size_t WS_PG = WS_PC + (size_t)L_ * 3072 * 2;
constexpr size_t WS_PLR = WS_PG + (size_t)L_ * 6144 * 2;
constexpr size_t WS_AA = WS_PLR + (size_t)L_ * 256 * 2;
constexpr size_t WS_ZT0 = WS_AA + (size_t)L_ * 512 * 2;
constexpr size_t WS_ZT1 = WS_ZT0 + (size_t)L_ * 512 * 2;
constexpr size_t WS_Z2T = WS_ZT1 + (size_t)L_ * 512 * 2;
constexpr size_t WS_G1T = WS_Z2T + (size_t)L_ * 512 * 2;
constexpr size_t WS_G2T = WS_G1T + (size_t)L_ * 512 * 2;
constexpr size_t WS_UPD = WS_G2T + (size_t)L_ * 512 * 2;
constexpr size_t WS_DEC = WS_UPD + (size_t)8 * 256 * 32768 * 2;
constexpr size_t WS_OC = WS_DEC + (size_t)8 * 256 * 128 * 4;
constexpr size_t WS_H3 = WS_OC + (size_t)L_ * 1024 * 2;
constexpr size_t WS_END = WS_H3 + (size_t)L_ * 64 * 2;

constexpr int LDS_BYTES = 147456;

struct Args { const float* in[29]; float* out; unsigned char* ws; int ph_lo, ph_hi; };

__device__ __forceinline__ void conv_w(const float* __restrict__ W, int K, int N, bf16_t* __restrict__ Wt, int nd64, int mode, float* tile) {
    const int tid = ltid(); const int nk4 = K >> 8; const int ntask = nk4 * nd64;
    for (int task = blockIdx.x; task < ntask; task += gridDim.x) {
        const int q = task / nk4, kt = task - q * nk4;
        int sc0, nvalid = 64;
        if (mode == 0) sc0 = q * 64;
        else if (mode == 1) { const int pn = q >> 2, sub = q & 3; sc0 = (sub >> 1) * F_ + pn * 128 + (sub & 1) * 64; }
        else { if (q < 96) sc0 = q * 64; else if (q < 192) sc0 = 6176 + (q - 96) * 64; else if (q == 192) { sc0 = 6144; nvalid = 32; } else { sc0 = 0; nvalid = 0; } }
        const int k0 = kt * 256;
        float4 v[8];
#pragma unroll
        for (int i = 0; i < 8; ++i) {
            const int r = (tid >> 4) + 32 * i, c4 = (tid & 15) * 4;
            v[i] = make_float4(0.f, 0.f, 0.f, 0.f);
            if (c4 < nvalid) v[i] = *(const float4*)(W + (size_t)(k0 + r) * N + sc0 + c4);
        }
#pragma unroll
        for (int i = 0; i < 8; ++i) {
            const int r = (tid >> 4) + 32 * i, c4 = (tid & 15) * 4;
            float* tp = tile + r * 65 + c4; tp[0] = v[i].x; tp[1] = v[i].y; tp[2] = v[i].z; tp[3] = v[i].w;
        }
        __syncthreads();
#pragma unroll
        for (int j = 0; j < 4; ++j) {
            const int n = tid >> 3, k8 = (tid & 7) * 8; const float* tp = tile + (j * 64 + k8) * 65 + n;
            u32x4 w; w.x = pk2(tp[0], tp[65]); w.y = pk2(tp[130], tp[195]); w.z = pk2(tp[260], tp[325]); w.w = pk2(tp[390], tp[455]);
            *(u32x4*)(Wt + (size_t)(q * 64 + n) * K + k0 + j * 64 + k8) = w;
        }
        __syncthreads();
    }
}

__device__ __forceinline__ void rms_rows_bf16(const float* __restrict__ src, const float* __restrict__ g, bf16_t* __restrict__ dst) {
    const int lane = ltid() & 63, wid = ltid() >> 6;
    for (int row = blockIdx.x * 8 + wid; row < L_; row += gridDim.x * 8) {
        const float* p = src + (size_t)row * D_; float4 v[8]; float ss = 0.f;
#pragma unroll
        for (int j = 0; j < 8; ++j) { v[j] = *(const float4*)(p + j * 256 + lane * 4); ss += v[j].x * v[j].x + v[j].y * v[j].y + v[j].z * v[j].z + v[j].w * v[j].w; }
#pragma unroll
        for (int o = 32; o >= 1; o >>= 1) ss += __shfl_xor(ss, o);
        const float sc = rsqrtf(ss * (1.f / 2048.f) + EPS_);
#pragma unroll
        for (int j = 0; j < 8; ++j) {
            const float4 gg = *(const float4*)(g + j * 256 + lane * 4);
            u32x2 w; w.x = pk2(v[j].x * sc * gg.x, v[j].y * sc * gg.y); w.y = pk2(v[j].z * sc * gg.z, v[j].w * sc * gg.w);
            *(u32x2*)(dst + (size_t)row * D_ + j * 256 + lane * 4) = w;
        }
    }
}
__device__ __forceinline__ void rms_rows_f32_inplace(float* __restrict__ buf, const float* __restrict__ g) {
    const int lane = ltid() & 63, wid = ltid() >> 6;
    for (int row = blockIdx.x * 8 + wid; row < L_; row += gridDim.x * 8) {
        float* p = buf + (size_t)row * D_; float4 v[8]; float ss = 0.f;
#pragma unroll
        for (int j = 0; j < 8; ++j) { v[j] = *(const float4*)(p + j * 256 + lane * 4); ss += v[j].x * v[j].x + v[j].y * v[j].y + v[j].z * v[j].z + v[j].w * v[j].w; }
#pragma unroll
        for (int o = 32; o >= 1; o >>= 1) ss += __shfl_xor(ss, o);
        const float sc = rsqrtf(ss * (1.f / 2048.f) + EPS_);
#pragma unroll
        for (int j = 0; j < 8; ++j) {
            const float4 gg = *(const float4*)(g + j * 256 + lane * 4);
            float4 o; o.x = v[j].x * sc * gg.x; o.y = v[j].y * sc * gg.y; o.z = v[j].z * sc * gg.z; o.w = v[j].w * sc * gg.w;
            *(float4*)(p + j * 256 + lane * 4) = o;
        }
    }
}

__device__ __forceinline__ void lr_proj(const bf16_t* __restrict__ XNr, const bf16_t* __restrict__ WCt, const float* __restrict__ biasp, bf16_t* __restrict__ PLR, unsigned char* sm) {
    const int tid = ltid(), lane = tid & 63, wid = tid >> 6, r = lane & 31, h = lane >> 5;
    float* part = (float*)sm;
    for (int base = blockIdx.x * 8; base < 2048; base += gridDim.x * 8) {
        f32x16 acc[2];
#pragma unroll
        for (int mi = 0; mi < 2; ++mi)
#pragma unroll
            for (int e = 0; e < 16; ++e) acc[mi][e] = 0.f;
        const bf16_t* a0 = XNr + (size_t)(base + (r & 7) + 2048 * (r >> 3)) * D_ + wid * 256 + 8 * h;
        const bf16_t* a1 = a0 + (size_t)4 * 2048 * D_;
        const bf16_t* b0 = WCt + (size_t)(12288 + r) * D_ + wid * 256 + 8 * h;
#pragma unroll 4
        for (int ks = 0; ks < 16; ++ks) {
            const bf16x8 bv = *(const bf16x8*)(b0 + ks * 16);
            const bf16x8 av0 = *(const bf16x8*)(a0 + ks * 16), av1 = *(const bf16x8*)(a1 + ks * 16);
            acc[0] = __builtin_amdgcn_mfma_f32_32x32x16_bf16(av0, bv, acc[0], 0, 0, 0);
            acc[1] = __builtin_amdgcn_mfma_f32_32x32x16_bf16(av1, bv, acc[1], 0, 0, 0);
        }
#pragma unroll
        for (int mi = 0; mi < 2; ++mi)
#pragma unroll
            for (int e = 0; e < 16; ++e) part[(wid * 64 + mi * 32 + (e & 3) + 8 * (e >> 2) + 4 * h) * 33 + r] = acc[mi][e];
        __syncthreads();
        {
            const int rr = tid >> 3, j0 = (tid & 7) * 4;
            float s[4] = {biasp[12288 + j0], biasp[12288 + j0 + 1], biasp[12288 + j0 + 2], biasp[12288 + j0 + 3]};
#pragma unroll
            for (int w = 0; w < 8; ++w)
#pragma unroll
                for (int j = 0; j < 4; ++j) s[j] += part[(w * 64 + rr) * 33 + j0 + j];
            u32x2 o; o.x = pk2(s[0], s[1]); o.y = pk2(s[2], s[3]);
            *(u32x2*)(PLR + (size_t)(base + (rr & 7) + 2048 * (rr >> 3)) * 256 + j0) = o;
        }
        __syncthreads();
    }
}

__device__ __forceinline__ void hyena_h3(const Args& a, int l, unsigned char* sm, _Float16* H3) {
    float* W1 = (float*)sm; float* W2 = W1 + 2112; float* W3 = W2 + 4096; float* B1 = W3 + 4096; float* B2 = B1 + 64; float* B3 = B2 + 64; float* FR = B3 + 64;
    float* bufA = FR + 64; float* bufB = bufA + 4160;
    const int tid = ltid();
    for (int i = tid; i < 2112; i += 512) W1[i] = a.in[9][(size_t)l * 2112 + i];
    for (int i = tid; i < 4096; i += 512) { W2[i] = a.in[11][(size_t)l * 4096 + i]; W3[i] = a.in[13][(size_t)l * 4096 + i]; }
    if (tid < 64) { B1[tid] = a.in[10][l * 64 + tid]; B2[tid] = a.in[12][l * 64 + tid]; B3[tid] = a.in[14][l * 64 + tid]; FR[tid] = a.in[16][l * 64 + tid]; }
    __syncthreads();
    const int pos = tid >> 3, q = tid & 7;
    for (int task = blockIdx.x; task < 256; task += gridDim.x) {
        const int t = task * 64 + pos; const float posf = (float)t;
        if (q == 0) bufA[pos * 65] = posf / 16383.f;
#pragma unroll
        for (int ii = 0; ii < 2; ++ii) {
            const int i = q + 8 * ii; const float band = 1e-4f + (float)i * ((15.f - 1e-4f) / 15.f);
            float rev = posf * band * (1.f / 16384.f); rev -= floorf(rev);
            bufA[pos * 65 + 1 + i] = __builtin_amdgcn_cosf(rev); bufA[pos * 65 + 17 + i] = -__builtin_amdgcn_sinf(rev);
        }
        __syncthreads();
        {   float acc[8];
#pragma unroll
            for (int jj = 0; jj < 8; ++jj) acc[jj] = B1[q * 8 + jj];
            for (int i = 0; i < 33; ++i) { const float x = bufA[pos * 65 + i];
#pragma unroll
                for (int jj = 0; jj < 8; ++jj) acc[jj] += x * W1[i * 64 + q * 8 + jj]; }
#pragma unroll
            for (int jj = 0; jj < 8; ++jj) bufB[pos * 65 + q * 8 + jj] = fsin_rad(FR[q * 8 + jj] * acc[jj]);
        }
        __syncthreads();
        {   float acc[8];
#pragma unroll
            for (int jj = 0; jj < 8; ++jj) acc[jj] = B2[q * 8 + jj];
            for (int i = 0; i < 64; ++i) { const float x = bufB[pos * 65 + i];
#pragma unroll
                for (int jj = 0; jj < 8; ++jj) acc[jj] += x * W2[i * 64 + q * 8 + jj]; }
#pragma unroll
            for (int jj = 0; jj < 8; ++jj) bufA[pos * 65 + q * 8 + jj] = fsin_rad(FR[q * 8 + jj] * acc[jj]);
        }
        __syncthreads();
        {   float acc[8];
#pragma unroll
            for (int jj = 0; jj < 8; ++jj) acc[jj] = B3[q * 8 + jj];
            for (int i = 0; i < 64; ++i) { const float x = bufA[pos * 65 + i];
#pragma unroll
                for (int jj = 0; jj < 8; ++jj) acc[jj] += x * W3[i * 64 + q * 8 + jj]; }
            typedef _Float16 h8 __attribute__((ext_vector_type(8)));
            h8 o;
#pragma unroll
            for (int jj = 0; jj < 8; ++jj) o[jj] = (_Float16)fsin_rad(FR[q * 8 + jj] * acc[jj]);
            *(h8*)(H3 + (size_t)t * 64 + q * 8) = o;
        }
        __syncthreads();
    }
}

__device__ __forceinline__ void branch_a_prep(const bf16_t* __restrict__ PA, const float* __restrict__ cw  , bf16_t* __restrict__ AA) {
#pragma unroll 2
    for (int idx = blockIdx.x * 512 + ltid(); idx < L_ * 64; idx += gridDim.x * 512) {
        const int t = idx >> 6, c8 = (idx & 63) * 8;
        const bf16_t* row = PA + (size_t)t * 3072 + c8;
        const u32x4 z4 = (u32x4){0u, 0u, 0u, 0u};
        const u32x4 xa0 = *(const u32x4*)row, ba0 = *(const u32x4*)(row + 512), ca0 = *(const u32x4*)(row + 1024);
        const u32x4 xam = t > 0 ? *(const u32x4*)(row - 3072) : z4, cam = t > 0 ? *(const u32x4*)(row - 3072 + 1024) : z4;
        const u32x4 xap = t < L_ - 1 ? *(const u32x4*)(row + 3072) : z4, cap = t < L_ - 1 ? *(const u32x4*)(row + 3072 + 1024) : z4;
        float x0[8], b0[8], c0[8], xm[8], cm[8], xp[8], cp[8];
        unpack8(xa0, x0); unpack8(ba0, b0); unpack8(ca0, c0); unpack8(xam, xm); unpack8(cam, cm); unpack8(xap, xp); unpack8(cap, cp);
        float w0[8], w1[8], w2[8];
        *(float4*)(w0) = *(const float4*)(cw + c8); *(float4*)(w0 + 4) = *(const float4*)(cw + c8 + 4);
        *(float4*)(w1) = *(const float4*)(cw + 512 + c8); *(float4*)(w1 + 4) = *(const float4*)(cw + 512 + c8 + 4);
        *(float4*)(w2) = *(const float4*)(cw + 1024 + c8); *(float4*)(w2 + 4) = *(const float4*)(cw + 1024 + c8 + 4);
        float o[8];
#pragma unroll
        for (int e = 0; e < 8; ++e) o[e] = b0[e] * (w0[e] * (cm[e] * xm[e]) + w1[e] * (c0[e] * x0[e]) + w2[e] * (cp[e] * xp[e]));
        u32x4 w; w.x = pk2(o[0], o[1]); w.y = pk2(o[2], o[3]); w.z = pk2(o[4], o[5]); w.w = pk2(o[6], o[7]);
        *(u32x4*)(AA + (size_t)t * 512 + c8) = w;
    }
}
__device__ __forceinline__ void hyena_prep(const bf16_t* __restrict__ PA, const float* __restrict__ cb  , bf16_t* ZT0, bf16_t* G1T, bf16_t* G2T) {
    const int c = ltid();
    for (int task = blockIdx.x; task < 768; task += gridDim.x) {
        const int arr = task >> 8, t0 = (task & 255) * 64;
        const float w0 = cb[(arr * 3 + 0) * 512 + c], w1 = cb[(arr * 3 + 1) * 512 + c], w2 = cb[(arr * 3 + 2) * 512 + c];
        const bf16_t* src = PA + 1536 + arr * 512 + c;
        bf16_t* dst = (arr == 0 ? ZT0 : (arr == 1 ? G1T : G2T)) + (size_t)c * L_ + t0;
        bf16_t raw[66];
#pragma unroll
        for (int k = 0; k < 66; ++k) { const int tt = t0 - 1 + k; raw[k] = (tt >= 0 && tt < L_) ? src[(size_t)tt * 3072] : (bf16_t)0; }
#pragma unroll
        for (int i8 = 0; i8 < 8; ++i8) {
            float o[8];
#pragma unroll
            for (int k = 0; k < 8; ++k) o[k] = w0 * bf2f(raw[i8 * 8 + k]) + w1 * bf2f(raw[i8 * 8 + k + 1]) + w2 * bf2f(raw[i8 * 8 + k + 2]);
            u32x4 w; w.x = pk2(o[0], o[1]); w.y = pk2(o[2], o[3]); w.z = pk2(o[4], o[5]); w.w = pk2(o[6], o[7]);
            *(u32x4*)(dst + i8 * 8) = w;
        }
    }
}

constexpr int G_GB = 0;
constexpr int G_W2 = 33024;
constexpr int G_BS = 41216;
constexpr int G_LR = 41728;
constexpr int G_TOT = 45824;
constexpr int G_QE = 47872;
constexpr int G_KE = 65280;
constexpr int G_VT = 82688;
constexpr int G_AA = 119552;
__device__ __forceinline__ void gla_b(const Args& a, int l, int hd, int dir, int t0, unsigned char* sm, const bf16_t* __restrict__ PLR) {
    float* Gb = (float*)(sm + G_GB); float* W2s = (float*)(sm + G_W2); float* Bs = (float*)(sm + G_BS); float* lrs = (float*)(sm + G_LR); float* tot = (float*)(sm + G_TOT);
    const int tid = ltid();
    const float* w2 = a.in[18] + ((size_t)(l * 2 + dir) * 16) * 512 + hd * 128;
    for (int i = tid; i < 2048; i += 512) W2s[i] = w2[(i >> 7) * 512 + (i & 127)];
    if (tid < 128) Bs[tid] = a.in[19][(l * 2 + dir) * 512 + hd * 128 + tid];
    for (int i = tid; i < 1024; i += 512) { const int j = i >> 4, r = i & 15; lrs[i] = bf2f(PLR[(size_t)(t0 + j) * 256 + dir * 16 + r]); }
    __syncthreads();
    const int d = tid & 127, q = tid >> 7;
    float run = 0.f;
    for (int k = 0; k < 16; ++k) {
        const int s = q * 16 + k, j = dir ? 63 - s : s;
        float x = Bs[d];
#pragma unroll
        for (int r = 0; r < 16; ++r) x += lrs[j * 16 + r] * W2s[r * 128 + d];
        const float g = (fminf(x, 0.f) - __logf(1.f + __expf(-fabsf(x)))) * (1.f / 16.f);
        run += g; Gb[j * 129 + d] = run;
    }
    tot[q * 128 + d] = run;
    __syncthreads();
    float off = 0.f;
    for (int qq = 0; qq < q; ++qq) off += tot[qq * 128 + d];
    if (q > 0) for (int k = 0; k < 16; ++k) { const int s = q * 16 + k, j = dir ? 63 - s : s; Gb[j * 129 + d] += off; }
    __syncthreads();
}
__device__ __forceinline__ void gla_load_vT(const bf16_t* __restrict__ PC, int hd, int t0, unsigned char* sm) {
    bf16_t* vT = (bf16_t*)(sm + G_VT);
    const int tid = ltid(), j = tid >> 3, v0 = (tid & 7) * 32;
    const bf16_t* vp = PC + (size_t)(t0 + j) * 3072 + 1024 + hd * 256 + v0;
#pragma unroll
    for (int i = 0; i < 4; ++i) {
        const u32x4 w = *(const u32x4*)(vp + i * 8);
        const int b = v0 + i * 8;
        vT[(b + 0) * 72 + j] = (bf16_t)(w.x & 0xffff); vT[(b + 1) * 72 + j] = (bf16_t)(w.x >> 16);
        vT[(b + 2) * 72 + j] = (bf16_t)(w.y & 0xffff); vT[(b + 3) * 72 + j] = (bf16_t)(w.y >> 16);
        vT[(b + 4) * 72 + j] = (bf16_t)(w.z & 0xffff); vT[(b + 5) * 72 + j] = (bf16_t)(w.z >> 16);
        vT[(b + 6) * 72 + j] = (bf16_t)(w.w & 0xffff); vT[(b + 7) * 72 + j] = (bf16_t)(w.w >> 16);
    }
}
__device__ __forceinline__ void gla_c1(const Args& a, int l, unsigned char* sm, const bf16_t* __restrict__ PC, const bf16_t* __restrict__ PLR, bf16_t* __restrict__ UPD, float* __restrict__ DEC) {
    const int tid = ltid(), lane = tid & 63, wid = tid >> 6, r = lane & 31, h = lane >> 5;
    float* Gb = (float*)(sm + G_GB); bf16_t* kdT = (bf16_t*)(sm + G_QE); bf16_t* vT = (bf16_t*)(sm + G_VT);
    for (int task = blockIdx.x; task < 2048; task += gridDim.x) {
        const int combo = task >> 8, n = task & 255, dir = combo >> 2, hd = combo & 3, t0 = n * 64;
        u32x4 kraw[2];
        { const bf16_t* kp = PC + (size_t)(t0 + (tid >> 3)) * 3072 + 512 + hd * 128 + (tid & 7) * 16; kraw[0] = *(const u32x4*)kp; kraw[1] = *(const u32x4*)(kp + 8); }
        gla_load_vT(PC, hd, t0, sm);
        gla_b(a, l, hd, dir, t0, sm, PLR);
        const int jb = dir ? 0 : 63;
        {
            const int j = tid >> 3, d0 = (tid & 7) * 16;
            float kv[16]; unpack8(kraw[0], kv); unpack8(kraw[1], kv + 8);
#pragma unroll
            for (int e = 0; e < 16; ++e) { const int d = d0 + e; kdT[d * 72 + j] = f2bf(kv[e] * __expf(Gb[jb * 129 + d] - Gb[j * 129 + d])); }
        }
        __syncthreads();
        f32x16 acc[4];
#pragma unroll
        for (int nt = 0; nt < 4; ++nt)
#pragma unroll
            for (int e = 0; e < 16; ++e) acc[nt][e] = 0.f;
#pragma unroll
        for (int ks = 0; ks < 4; ++ks) {
            const bf16x8 av = *(const bf16x8*)(vT + (32 * wid + r) * 72 + ks * 16 + 8 * h);
#pragma unroll
            for (int nt = 0; nt < 4; ++nt) { const bf16x8 bv = *(const bf16x8*)(kdT + (32 * nt + r) * 72 + ks * 16 + 8 * h); acc[nt] = __builtin_amdgcn_mfma_f32_32x32x16_bf16(av, bv, acc[nt], 0, 0, 0); }
        }
        bf16_t* up = UPD + ((size_t)(combo * 256 + n)) * 32768;
#pragma unroll
        for (int nt = 0; nt < 4; ++nt)
#pragma unroll
            for (int e = 0; e < 16; ++e) { const int dv = 32 * wid + (e & 3) + 8 * (e >> 2) + 4 * h, dk = 32 * nt + r; up[dv * 128 + dk] = f2bf(acc[nt][e]); }
        if (tid < 128) DEC[(size_t)(combo * 256 + n) * 128 + tid] = __expf(Gb[jb * 129 + tid]);
        __syncthreads();
    }
}
__device__ __forceinline__ void gla_scan(bf16_t* __restrict__ UPD, const float* __restrict__ DEC) {
    for (int idx = blockIdx.x * 512 + ltid(); idx < 131072; idx += gridDim.x * 512) {
        const int combo = idx >> 14, rem = idx & 16383, dv = rem >> 6, dk = (rem & 63) * 2, dir = combo >> 2;
        unsigned* up = (unsigned*)(UPD + (size_t)combo * 256 * 32768 + dv * 128 + dk);
        const float* dp = DEC + (size_t)combo * 256 * 128 + dk;
        float s0 = 0.f, s1 = 0.f;
        unsigned uv[8], un[8]; float2 dc[8], dn[8];
#pragma unroll
        for (int k = 0; k < 8; ++k) { const int n = dir ? 255 - k : k; uv[k] = up[(size_t)n * 16384]; dc[k] = *(const float2*)(dp + n * 128); }
        for (int nb = 0; nb < 256; nb += 8) {
            if (nb + 8 < 256) {
#pragma unroll
                for (int k = 0; k < 8; ++k) { const int n = dir ? 255 - (nb + 8 + k) : nb + 8 + k; un[k] = up[(size_t)n * 16384]; dn[k] = *(const float2*)(dp + n * 128); }
            }
#pragma unroll
            for (int k = 0; k < 8; ++k) { const int n = dir ? 255 - (nb + k) : nb + k; up[(size_t)n * 16384] = pk2(s0, s1); s0 = dc[k].x * s0 + bflo(uv[k]); s1 = dc[k].y * s1 + bfhi(uv[k]); }
#pragma unroll
            for (int k = 0; k < 8; ++k) { uv[k] = un[k]; dc[k] = dn[k]; }
        }
    }
}
__device__ __forceinline__ void gla_c3(const Args& a, int l, unsigned char* sm, const bf16_t* __restrict__ PC, const bf16_t* __restrict__ PLR, const bf16_t* __restrict__ UPD, bf16_t* __restrict__ OC) {
    const int tid = ltid(), lane = tid & 63, wid = tid >> 6, r = lane & 31, h = lane >> 5;
    float* Gb = (float*)(sm + G_GB); bf16_t* qeL = (bf16_t*)(sm + G_QE); bf16_t* keL = (bf16_t*)(sm + G_KE); bf16_t* vT = (bf16_t*)(sm + G_VT); bf16_t* Aa = (bf16_t*)(sm + G_AA);
    const float* gn = a.in[20] + l * 256;
    for (int task = blockIdx.x; task < 1024; task += gridDim.x) {
        const int hd = task >> 8, n = task & 255, t0 = n * 64;
        gla_load_vT(PC, hd, t0, sm);
        f32x16 accO[2];
#pragma unroll
        for (int mi = 0; mi < 2; ++mi)
#pragma unroll
            for (int e = 0; e < 16; ++e) accO[mi][e] = 0.f;
        for (int dir = 0; dir < 2; ++dir) {
            const bf16_t* Sg = UPD + ((size_t)((dir * 4 + hd) * 256 + n)) * 32768;
            bf16x8 sfr[8];
#pragma unroll
            for (int ks = 0; ks < 8; ++ks) sfr[ks] = *(const bf16x8*)(Sg + (32 * wid + r) * 128 + ks * 16 + 8 * h);
            u32x4 qraw[2], kraw[2];
            { const bf16_t* qp = PC + (size_t)(t0 + (tid >> 3)) * 3072 + hd * 128 + (tid & 7) * 16;
              qraw[0] = *(const u32x4*)qp; qraw[1] = *(const u32x4*)(qp + 8); kraw[0] = *(const u32x4*)(qp + 512); kraw[1] = *(const u32x4*)(qp + 520); }
            gla_b(a, l, hd, dir, t0, sm, PLR);
            {
                const int j = tid >> 3, d0 = (tid & 7) * 16;
                float qv[16], kv[16];
                unpack8(qraw[0], qv); unpack8(qraw[1], qv + 8);
                unpack8(kraw[0], kv); unpack8(kraw[1], kv + 8);
                float qo[16], ko[16];
#pragma unroll
                for (int e = 0; e < 16; ++e) { const float b = Gb[j * 129 + d0 + e]; qo[e] = qv[e] * 0.08838834764831845f * __expf(b); ko[e] = kv[e] * __expf(-b); }
                u32x4 w;
                w.x = pk2(qo[0], qo[1]); w.y = pk2(qo[2], qo[3]); w.z = pk2(qo[4], qo[5]); w.w = pk2(qo[6], qo[7]); *(u32x4*)(qeL + j * 136 + d0) = w;
                w.x = pk2(qo[8], qo[9]); w.y = pk2(qo[10], qo[11]); w.z = pk2(qo[12], qo[13]); w.w = pk2(qo[14], qo[15]); *(u32x4*)(qeL + j * 136 + d0 + 8) = w;
                w.x = pk2(ko[0], ko[1]); w.y = pk2(ko[2], ko[3]); w.z = pk2(ko[4], ko[5]); w.w = pk2(ko[6], ko[7]); *(u32x4*)(keL + j * 136 + d0) = w;
                w.x = pk2(ko[8], ko[9]); w.y = pk2(ko[10], ko[11]); w.z = pk2(ko[12], ko[13]); w.w = pk2(ko[14], ko[15]); *(u32x4*)(keL + j * 136 + d0 + 8) = w;
            }
            __syncthreads();
            if (wid < 4) {
                const int mi = wid >> 1, ni = wid & 1;
                f32x16 s;
#pragma unroll
                for (int e = 0; e < 16; ++e) s[e] = 0.f;
#pragma unroll
                for (int ks = 0; ks < 8; ++ks) {
                    const bf16x8 av = *(const bf16x8*)(qeL + (32 * mi + r) * 136 + ks * 16 + 8 * h);
                    const bf16x8 bv = *(const bf16x8*)(keL + (32 * ni + r) * 136 + ks * 16 + 8 * h);
                    s = __builtin_amdgcn_mfma_f32_32x32x16_bf16(av, bv, s, 0, 0, 0);
                }
#pragma unroll
                for (int e = 0; e < 16; ++e) { const int i = 32 * mi + (e & 3) + 8 * (e >> 2) + 4 * h, j = 32 * ni + r; const bool keep = dir ? (j >= i) : (j <= i); Aa[i * 72 + j] = f2bf(keep ? s[e] : 0.f); }
            }
            __syncthreads();
#pragma unroll
            for (int mi = 0; mi < 2; ++mi) {
#pragma unroll
                for (int ks = 0; ks < 4; ++ks) {
                    const bf16x8 av = *(const bf16x8*)(Aa + (32 * mi + r) * 72 + ks * 16 + 8 * h);
                    const bf16x8 bv = *(const bf16x8*)(vT + (32 * wid + r) * 72 + ks * 16 + 8 * h);
                    accO[mi] = __builtin_amdgcn_mfma_f32_32x32x16_bf16(av, bv, accO[mi], 0, 0, 0);
                }
#pragma unroll
                for (int ks = 0; ks < 8; ++ks) {
                    const bf16x8 av = *(const bf16x8*)(qeL + (32 * mi + r) * 136 + ks * 16 + 8 * h);
                    accO[mi] = __builtin_amdgcn_mfma_f32_32x32x16_bf16(av, sfr[ks], accO[mi], 0, 0, 0);
                }
            }
            __syncthreads();
        }
        float* Of = (float*)sm;
#pragma unroll
        for (int mi = 0; mi < 2; ++mi)
#pragma unroll
            for (int e = 0; e < 16; ++e) { const int i = 32 * mi + (e & 3) + 8 * (e >> 2) + 4 * h; Of[i * 260 + 32 * wid + r] = accO[mi][e]; }
        __syncthreads();
        bf16_t rgv[8][4];
#pragma unroll
        for (int rr = 0; rr < 8; ++rr)
#pragma unroll
            for (int q = 0; q < 4; ++q) rgv[rr][q] = PC[(size_t)(t0 + 8 * wid + rr) * 3072 + 2048 + hd * 256 + lane + 64 * q];
#pragma unroll
        for (int rr = 0; rr < 8; ++rr) {
            const int i = 8 * wid + rr, t = t0 + i;
            float v[4]; float ss = 0.f;
#pragma unroll
            for (int q = 0; q < 4; ++q) { v[q] = Of[i * 260 + lane + 64 * q]; ss += v[q] * v[q]; }
#pragma unroll
            for (int o = 32; o >= 1; o >>= 1) ss += __shfl_xor(ss, o);
            const float sc = rsqrtf(ss * (1.f / 256.f) + EPS_);
#pragma unroll
            for (int q = 0; q < 4; ++q) {
                const int col = lane + 64 * q;
                const float rg = bf2f(rgv[rr][q]);
                OC[(size_t)t * 1024 + hd * 256 + col] = f2bf(v[q] * sc * gn[col] * siluf_(rg));
            }
        }
        __syncthreads();
    }
}

constexpr int C_K = 0;
constexpr int C_Z = 65536;
constexpr int C_W = 98304;
constexpr int C_RED = 98816;
__device__ __forceinline__ void conv_build_filter(const Args& a, int l, int o, int c, unsigned char* sm, const _Float16* __restrict__ H3) {
    bf16_t* Kl = (bf16_t*)(sm + C_K); float* wl = (float*)(sm + C_W); float* red = (float*)(sm + C_RED);
    const int tid = ltid(), lane = tid & 63, wid = tid >> 6;
    const float* wo = a.in[15] + (size_t)l * 64 * 2048;
    if (tid < 128) wl[tid] = wo[(size_t)(tid & 63) * 2048 + o * 1024 + (tid >> 6) * 512 + c];
    if (tid == 0) Kl[0] = 0;
    __syncthreads();
    const float da = -3.0701134573253944f, db = -15.350567286626972f;
    const float adelta = fabsf(da + (float)c * ((db - da) / 511.f));
    float sf = 0.f, sb = 0.f;
    typedef _Float16 h8 __attribute__((ext_vector_type(8)));
    for (int i = 0; i < 32; ++i) {
        const int t = tid + 512 * i;
        const h8* hp = (const h8*)(H3 + (size_t)t * 64);
        float f = 0.f, b = 0.f;
#pragma unroll
        for (int k8 = 0; k8 < 8; ++k8) { const h8 hv = hp[k8];
#pragma unroll
            for (int e = 0; e < 8; ++e) { const float x = (float)hv[e]; f += x * wl[k8 * 8 + e]; b += x * wl[64 + k8 * 8 + e]; } }
        const float dec = __expf(-((float)t / 16383.f) * adelta);
        f *= dec; b *= dec; sf += fabsf(f); sb += fabsf(b);
        Kl[L_ + t] = f2bf(f);
        if (t > 0) Kl[L_ - t] = f2bf(b);
    }
#pragma unroll
    for (int ofs = 32; ofs >= 1; ofs >>= 1) { sf += __shfl_xor(sf, ofs); sb += __shfl_xor(sb, ofs); }
    if (lane == 0) { red[wid] = sf; red[8 + wid] = sb; }
    __syncthreads();
    float tf = 0.f, tb = 0.f;
#pragma unroll
    for (int w = 0; w < 8; ++w) { tf += red[w]; tb += red[8 + w]; }
    const float invf = 1.f / (tf + EPS_), invb = 1.f / (tb + EPS_);
    for (int x = tid; x < 32768; x += 512) { const float v = bf2f(Kl[x]); Kl[x] = f2bf(v * (x >= L_ ? invf : invb)); }
    __syncthreads();
}
__device__ __forceinline__ void hyena_conv_scalar(const Args& a, int l, int o, unsigned char* sm, const _Float16* __restrict__ H3,
                                                  const bf16_t* __restrict__ ZinT, const bf16_t* __restrict__ GT, bf16_t* __restrict__ OutT) {
    bf16_t* Kl = (bf16_t*)(sm + C_K); bf16_t* zl = (bf16_t*)(sm + C_Z);
    const int tid = ltid();
    for (int c = blockIdx.x; c < 512; c += gridDim.x) {
        conv_build_filter(a, l, o, c, sm, H3);
        for (int i = tid; i < 2048; i += 512) *(u32x4*)(zl + i * 8) = *(const u32x4*)(ZinT + (size_t)c * L_ + i * 8);
        __syncthreads();
        float acc[32];
#pragma unroll
        for (int j = 0; j < 32; ++j) acc[j] = 0.f;
        const bf16_t* kb = Kl + L_ + tid;
        for (int s = 0; s < L_; ++s) {
            const float zs = bf2f(zl[s]);
#pragma unroll
            for (int j = 0; j < 32; ++j) acc[j] += bf2f(kb[512 * j - s]) * zs;
        }
        const float skip = a.in[17][(l * 2 + o) * 512 + c];
#pragma unroll
        for (int j = 0; j < 32; ++j) {
            const int t = tid + 512 * j;
            const float zp = bf2f(zl[t]), gt = bf2f(GT[(size_t)c * L_ + t]);
            OutT[(size_t)c * L_ + t] = f2bf(gt * (acc[j] + skip * zp));
        }
        __syncthreads();
    }
}
typedef _Float16 h8_t __attribute__((ext_vector_type(8)));
__device__ __forceinline__ void hyena_filtgen(const Args& a, int l, int o, const _Float16* __restrict__ H3, bf16_t* __restrict__ FILT, u64_t* __restrict__ FSUM) {
    const int tid = ltid(), lane = tid & 63, wid = tid >> 6, r = lane & 31, h = lane >> 5;
    for (int task = blockIdx.x; task < 256; task += gridDim.x) {
        const int cg = task >> 3, part = task & 7;
        const float* wo = a.in[15] + (size_t)l * 64 * 2048 + o * 1024 + cg * 32 + r;
        h8_t wa[4];
#pragma unroll
        for (int ks = 0; ks < 4; ++ks)
#pragma unroll
            for (int e = 0; e < 8; ++e) wa[ks][e] = (_Float16)wo[(size_t)(ks * 16 + 8 * h + e) * 2048];
        const float da = -3.0701134573253944f, db = -15.350567286626972f;
        float adl[16], sabs[16];
#pragma unroll
        for (int e = 0; e < 16; ++e) { const int c = (cg * 32 + (e & 3) + 8 * (e >> 2) + 4 * h) & 511; adl[e] = fabsf(da + (float)c * ((db - da) / 511.f)) * (1.f / 16383.f); sabs[e] = 0.f; }
#pragma unroll 1
        for (int qt = 0; qt < 4; ++qt) {
            h8_t hb[2][4];
#pragma unroll
            for (int i = 0; i < 2; ++i) { const _Float16* hp = H3 + (size_t)(part * 2048 + (wid * 8 + qt * 2 + i) * 32 + r) * 64 + 8 * h;
#pragma unroll
                for (int ks = 0; ks < 4; ++ks) hb[i][ks] = *(const h8_t*)(hp + ks * 16); }
#pragma unroll
            for (int i = 0; i < 2; ++i) {
                f32x16 d;
#pragma unroll
                for (int e = 0; e < 16; ++e) d[e] = 0.f;
#pragma unroll
                for (int ks = 0; ks < 4; ++ks) d = __builtin_amdgcn_mfma_f32_32x32x16_f16(wa[ks], hb[i][ks], d, 0, 0, 0);
                const int t = part * 2048 + (wid * 8 + qt * 2 + i) * 32 + r; const float tf = (float)t;
#pragma unroll
                for (int e = 0; e < 16; ++e) {
                    const float v = d[e] * __expf(-tf * adl[e]);
                    sabs[e] += fabsf(v);
                    FILT[(size_t)(cg * 32 + (e & 3) + 8 * (e >> 2) + 4 * h) * L_ + t] = f2bf(v);
                }
            }
        }
#pragma unroll
        for (int e = 0; e < 16; ++e) {
            float s = sabs[e];
#pragma unroll
            for (int ofs = 16; ofs >= 1; ofs >>= 1) s += __shfl_xor(s, ofs);
            if (r == 0) atomicAdd(FSUM + cg * 32 + (e & 3) + 8 * (e >> 2) + 4 * h, (u64_t)(s * FS_FIX + 0.5f));
        }
    }
}
constexpr int M_PAD = 4096;
constexpr int M_ZN = L_ + 2 * M_PAD + 256;
constexpr int M_K = 0;
constexpr int M_Z = 66560;
constexpr int M_W = 119808;
constexpr int M_RED = 120320;
__device__ __forceinline__ int zpad(int idx) { return idx + ((idx >> 7) << 3); }
__device__ __forceinline__ bf16x8 ld_kfrag(const unsigned* kd, int x0, unsigned sh) {
    const int dw = x0 >> 1;
    const unsigned d0 = kd[dw], d1 = kd[dw + 1], d2 = kd[dw + 2], d3 = kd[dw + 3], d4 = kd[dw + 4];
    u32x4 o;
    o.x = __builtin_amdgcn_alignbit(d1, d0, sh); o.y = __builtin_amdgcn_alignbit(d2, d1, sh); o.z = __builtin_amdgcn_alignbit(d3, d2, sh); o.w = __builtin_amdgcn_alignbit(d4, d3, sh);
    return __builtin_bit_cast(bf16x8, o);
}
__device__ __forceinline__ unsigned swap16(unsigned w) { return (w >> 16) | (w << 16); }
__device__ __forceinline__ void hyena_conv_mfma(const Args& a, int l, int o, unsigned char* sm, const bf16_t* __restrict__ FILT, const u64_t* __restrict__ FSUM,
                                                const bf16_t* __restrict__ ZinT, const bf16_t* __restrict__ GT, bf16_t* __restrict__ OutT) {
    bf16_t* Kl = (bf16_t*)(sm + M_K); bf16_t* zp = (bf16_t*)(sm + M_Z);
    const int tid = ltid(), lane = tid & 63, wid = tid >> 6, r = lane & 31, h = lane >> 5, wk = wid >> 2, wn = wid & 3;
    for (int c = blockIdx.x; c < 512; c += gridDim.x) {
        {
            if (tid < 256) ((unsigned*)(sm + 65536))[tid] = 0u;
            if (tid == 0) Kl[0] = 0;
            const float invf = 1.f / ((float)FSUM[c] * (1.f / FS_FIX) + EPS_), invb = 1.f / ((float)FSUM[512 + c] * (1.f / FS_FIX) + EPS_);
            u32x4 fv[4];
#pragma unroll
            for (int j = 0; j < 4; ++j) fv[j] = *(const u32x4*)(FILT + (size_t)c * L_ + (tid + 512 * j) * 8);
#pragma unroll
            for (int j = 0; j < 4; ++j) {
                const int t8 = (tid + 512 * j) * 8;
                float x[8]; unpack8(fv[j], x);
                u32x4 w; w.x = pk2(x[0] * invf, x[1] * invf); w.y = pk2(x[2] * invf, x[3] * invf); w.z = pk2(x[4] * invf, x[5] * invf); w.w = pk2(x[6] * invf, x[7] * invf);
                *(u32x4*)(Kl + L_ + t8) = w;
            }
#pragma unroll
            for (int j = 0; j < 4; ++j) fv[j] = *(const u32x4*)(FILT + (size_t)(512 + c) * L_ + (tid + 512 * j) * 8);
#pragma unroll
            for (int j = 0; j < 4; ++j) {
                const int t8 = (tid + 512 * j) * 8;
                float x[8]; unpack8(fv[j], x);
#pragma unroll
                for (int e = 0; e < 8; ++e) if (t8 + e > 0) Kl[L_ - t8 - e] = f2bf(x[e] * invb);
            }
        }
        {
            u32x4 zv[7];
#pragma unroll
            for (int it = 0; it < 7; ++it) {
                const int idx0 = (tid + 512 * it) * 8; zv[it] = (u32x4){0u, 0u, 0u, 0u};
                if (idx0 >= M_PAD && idx0 < M_PAD + L_) zv[it] = *(const u32x4*)(ZinT + (size_t)c * L_ + (L_ + M_PAD - 8 - idx0));
            }
#pragma unroll
            for (int it = 0; it < 7; ++it) {
                const int idx0 = (tid + 512 * it) * 8;
                if (idx0 < M_ZN) { u32x4 w; w.x = swap16(zv[it].w); w.y = swap16(zv[it].z); w.z = swap16(zv[it].y); w.w = swap16(zv[it].x); *(u32x4*)(zp + zpad(idx0)) = w; }
            }
        }
        __syncthreads();
        const unsigned* kd = (const unsigned*)Kl;
        const int r16 = lane & 15, kg = lane >> 4;
        const int n0 = 32 * wn, sb0 = 4 * n0 + 320 * wk;
        const unsigned sh = ((1 + r16) & 1) * 16;
        const int xb = 1 + 8 * kg + r16 + 32 * sb0;
        const int zi0 = M_PAD - (n0 + r16) * 128 + 8 * kg + 32 * sb0;
        f32x4 acc[8][2];
#pragma unroll
        for (int q = 0; q < 8; ++q)
#pragma unroll
            for (int cc = 0; cc < 2; ++cc) acc[q][cc] = (f32x4){0.f, 0.f, 0.f, 0.f};
        {
        bf16x8 R[10];
#pragma unroll
        for (int m = 0; m < 6; ++m) R[m] = ld_kfrag(kd, xb + 16 * m, sh);
        unsigned ra[5], rb[5];
        { const int dwa = (xb + 16 * 6) >> 1, dwb = (xb + 16 * 7) >> 1;
#pragma unroll
          for (int e = 0; e < 5; ++e) { ra[e] = kd[dwa + e]; rb[e] = kd[dwb + e]; } }
        bf16x8 zr0 = *(const bf16x8*)(zp + zpad(zi0)), zr1 = *(const bf16x8*)(zp + zpad(zi0 - 16 * 128));
        for (int it = 0; it < 64; ++it) {
#pragma unroll
            for (int u = 0; u < 5; ++u) {
                const int j = it * 5 + u;
                { u32x4 oa, ob;
                  oa.x = __builtin_amdgcn_alignbit(ra[1], ra[0], sh); oa.y = __builtin_amdgcn_alignbit(ra[2], ra[1], sh); oa.z = __builtin_amdgcn_alignbit(ra[3], ra[2], sh); oa.w = __builtin_amdgcn_alignbit(ra[4], ra[3], sh);
                  ob.x = __builtin_amdgcn_alignbit(rb[1], rb[0], sh); ob.y = __builtin_amdgcn_alignbit(rb[2], rb[1], sh); ob.z = __builtin_amdgcn_alignbit(rb[3], rb[2], sh); ob.w = __builtin_amdgcn_alignbit(rb[4], rb[3], sh);
                  R[(2 * u + 6) % 10] = __builtin_bit_cast(bf16x8, oa); R[(2 * u + 7) % 10] = __builtin_bit_cast(bf16x8, ob); }
                const bf16x8 zb0 = zr0, zb1 = zr1;
                { const int dwa = (xb + 16 * (2 * j + 8)) >> 1, dwb = (xb + 16 * (2 * j + 9)) >> 1;
#pragma unroll
                  for (int e = 0; e < 5; ++e) { ra[e] = kd[dwa + e]; rb[e] = kd[dwb + e]; } }
                zr0 = *(const bf16x8*)(zp + zpad(zi0 + 32 * (j + 1))); zr1 = *(const bf16x8*)(zp + zpad(zi0 + 32 * (j + 1) - 16 * 128));
                __builtin_amdgcn_sched_barrier(0);
#pragma unroll
                for (int q = 0; q < 8; ++q) {
                    acc[q][0] = __builtin_amdgcn_mfma_f32_16x16x32_bf16(R[(2 * u + q) % 10], zb0, acc[q][0], 0, 0, 0);
                    acc[q][1] = __builtin_amdgcn_mfma_f32_16x16x32_bf16(R[(2 * u + q) % 10], zb1, acc[q][1], 0, 0, 0);
                }
                __builtin_amdgcn_sched_barrier(0);
            }
        }
        }
        __syncthreads();
        float* yb = (float*)(sm + M_K);
        if (wk == 0) {
#pragma unroll
            for (int q = 0; q < 8; ++q)
#pragma unroll
                for (int cc = 0; cc < 2; ++cc)
#pragma unroll
                    for (int e = 0; e < 4; ++e) yb[(n0 + 16 * cc + r16) * 129 + 16 * q + 4 * kg + e] = acc[q][cc][e];
        }
        __syncthreads();
        if (wk == 1) {
#pragma unroll
            for (int q = 0; q < 8; ++q)
#pragma unroll
                for (int cc = 0; cc < 2; ++cc)
#pragma unroll
                    for (int e = 0; e < 4; ++e) yb[(n0 + 16 * cc + r16) * 129 + 16 * q + 4 * kg + e] += acc[q][cc][e];
        }
        __syncthreads();
        const float skip = a.in[17][(l * 2 + o) * 512 + c];
        u32x4 gv4[4];
#pragma unroll
        for (int j = 0; j < 4; ++j) gv4[j] = *(const u32x4*)(GT + (size_t)c * L_ + (tid + 512 * j) * 8);
#pragma unroll
        for (int j = 0; j < 4; ++j) {
            const int t8 = (tid + 512 * j) * 8;
            const u32x4 zr = *(const u32x4*)(zp + zpad(L_ + M_PAD - 8 - t8));
            float zv[8], gg[8], ov[8];
            unpack8(zr, zv); unpack8(gv4[j], gg);
            const float* yp = yb + (t8 >> 7) * 129 + (t8 & 127);
#pragma unroll
            for (int e = 0; e < 8; ++e) ov[e] = gg[e] * (yp[e] + skip * zv[7 - e]);
            u32x4 w; w.x = pk2(ov[0], ov[1]); w.y = pk2(ov[2], ov[3]); w.z = pk2(ov[4], ov[5]); w.w = pk2(ov[6], ov[7]);
            *(u32x4*)(OutT + (size_t)c * L_ + t8) = w;
        }
        __syncthreads();
    }
}
__device__ __forceinline__ void transpose_z(const bf16_t* __restrict__ ZT, bf16_t* __restrict__ ZB, unsigned char* sm) {
    bf16_t* tile = (bf16_t*)sm;
    const int tid = ltid();
    for (int task4 = blockIdx.x; task4 < 512; task4 += gridDim.x) {
        const int c0 = (task4 >> 6) * 64, t0 = (task4 & 63) * 256;
        { const int cc = tid >> 3, t8 = (tid & 7) * 8;
          u32x4 v[4];
#pragma unroll
          for (int q = 0; q < 4; ++q) v[q] = *(const u32x4*)(ZT + (size_t)(c0 + cc) * L_ + t0 + q * 64 + t8);
#pragma unroll
          for (int q = 0; q < 4; ++q) *(u32x4*)(tile + q * 4608 + cc * 72 + t8) = v[q]; }
        __syncthreads();
        { const int tt = tid >> 3, c8 = (tid & 7) * 8;
#pragma unroll
          for (int q = 0; q < 4; ++q) {
              unsigned w[4];
#pragma unroll
              for (int k = 0; k < 4; ++k) w[k] = (unsigned)tile[q * 4608 + (c8 + 2 * k) * 72 + tt] | ((unsigned)tile[q * 4608 + (c8 + 2 * k + 1) * 72 + tt] << 16);
              *(u32x4*)(ZB + (size_t)(t0 + q * 64 + tt) * 512 + c0 + c8) = (u32x4){w[0], w[1], w[2], w[3]}; } }
        __syncthreads();
    }
}

#define XB_TMO      128
#define XB_XCNT(j)  (256  + 64 * (j))
#define XB_XSUB(j)  (1280 + 64 * (j))
#define XB_XGEN(j)  (2304 + 64 * (j))
#define XB_TOP      3328
#define XB_TOPGEN   3392
#define XCD_BAR_WORDS 3456
#define XB_SPIN_CAP (1u << 22)
__device__ __forceinline__ unsigned xb_ld(unsigned* p)              { return __hip_atomic_load(p, __ATOMIC_RELAXED, __HIP_MEMORY_SCOPE_AGENT); }
__device__ __forceinline__ unsigned xb_add(unsigned* p, unsigned v) { return __hip_atomic_fetch_add(p, v, __ATOMIC_RELAXED, __HIP_MEMORY_SCOPE_AGENT); }
__device__ __forceinline__ unsigned xb_xcc_id() { return (unsigned)__builtin_amdgcn_s_getreg((3 << 11) | 20) & 0xFu; }
#define XB_SPIN(cond, bar) do { unsigned _sp = 0; while (cond) { __builtin_amdgcn_s_sleep(1); \
    if ((++_sp & 255u) == 0u) { if (xb_ld(&(bar)[XB_TMO])) break; if (_sp > XB_SPIN_CAP) { atomicAdd(&(bar)[XB_TMO], 1u); break; } } } } while (0)
struct XcdBarrier { unsigned* bar; unsigned x; volatile PG8_LAS unsigned* st; };
__device__ __forceinline__ XcdBarrier xcd_barrier_post(unsigned* bar, volatile PG8_LAS unsigned* st) {
    XcdBarrier b; b.bar = bar; b.x = xb_xcc_id(); b.st = st;
    if (threadIdx.x == 0) (void)xb_add(&bar[XB_XCNT(b.x)], 1u);
    return b;
}
__device__ __forceinline__ void xcd_barrier_complete(unsigned* bar, unsigned x, unsigned& nloc, unsigned& nx) {
    const unsigned G = gridDim.x * gridDim.y * gridDim.z;
    unsigned sum, cnt, mine, sp = 0u;
    for (;;) {
        sum = 0u; cnt = 0u; mine = 0u;
#pragma unroll
        for (unsigned j = 0; j < 16; ++j) { const unsigned c = xb_ld(&bar[XB_XCNT(j)]); sum += c; cnt += (c > 0u) ? 1u : 0u; mine = (j == x) ? c : mine; }
        if (sum == G) break;
        __builtin_amdgcn_s_sleep(1);
        if ((++sp & 255u) == 0u) { if (xb_ld(&bar[XB_TMO])) break; if (sp > XB_SPIN_CAP) { atomicAdd(&bar[XB_TMO], 1u); break; } }
    }
    nloc = mine > 0u ? mine : 1u; nx = cnt > 0u ? cnt : 1u;
}
__device__ __forceinline__ void xcd_barrier(const XcdBarrier& b) {
    asm volatile("s_waitcnt vmcnt(0)" ::: "memory");
    __syncthreads();
    if (threadIdx.x == 0) {
        unsigned* bar = b.bar;
        __builtin_amdgcn_s_waitcnt(0);
        unsigned nloc = b.st[0], nx = b.st[1];
        if (nloc == 0u) { xcd_barrier_complete(bar, b.x, nloc, nx); b.st[0] = nloc; b.st[1] = nx; }
        const unsigned old = xb_add(&bar[XB_XSUB(b.x)], 1u);
        const unsigned gen = old / nloc;
        if (old + 1u == (gen + 1u) * nloc) {
            __builtin_amdgcn_fence(__ATOMIC_RELEASE, "agent");
            asm volatile("s_waitcnt vmcnt(0)" ::: "memory");
            const unsigned og = xb_add(&bar[XB_TOP], 1u);
            const unsigned tg = og / nx;
            if (og + 1u == (tg + 1u) * nx) xb_add(&bar[XB_TOPGEN], 1u);
            else XB_SPIN(xb_ld(&bar[XB_TOPGEN]) == tg, bar);
            __builtin_amdgcn_fence(__ATOMIC_ACQUIRE, "agent");
            xb_add(&bar[XB_XGEN(b.x)], 1u);
            asm volatile("s_waitcnt vmcnt(0)" ::: "memory");
        } else {
            XB_SPIN(xb_ld(&bar[XB_XGEN(b.x)]) == gen, bar);
            __builtin_amdgcn_fence(__ATOMIC_ACQUIRE, "agent");
            asm volatile("s_waitcnt vmcnt(0)" ::: "memory");
        }
    }
    __syncthreads();
}

__global__ void __launch_bounds__(512, 2) mega(Args a) {
    extern __shared__ __attribute__((aligned(16))) unsigned char smem[];
    cg::grid_group grid = cg::this_grid();
    PG8_LAS unsigned char* lds = (PG8_LAS unsigned char*)smem;
    const int G = gridDim.x, bid = blockIdx.x;
    volatile PG8_LAS unsigned* xst = (volatile PG8_LAS unsigned*)(lds + (LDS_BYTES - 16));
    if (threadIdx.x < 4) xst[threadIdx.x] = 0u;
    __syncthreads();
    const XcdBarrier xbar = xcd_barrier_post((unsigned*)(a.ws + WS_CTL), xst);
    for (int ph = a.ph_lo; ph < a.ph_hi && ph < 29; ++ph) {
        unsigned long long zoff = 0; asm volatile("" : "+s"(zoff));
        unsigned char* ws = a.ws + zoff;
        float* OUT = a.out;
        bf16_t* XN = (bf16_t*)(ws + WS_XN); bf16_t* PG = (bf16_t*)(ws + WS_PG);
        const int l = ph / 14, k = ph - l * 14;
        if (ph == 28) { rms_rows_f32_inplace(OUT, a.in[28]); }
        else for (int rep = 0; rep < ((ph == REPK) ? REPN : 1); ++rep) {
            if (rep) xcd_barrier(xbar);
            if (k == 0 || k == 3) {
                const int w0 = k == 0 ? 0 : 7, w1 = k == 0 ? 7 : 9;
                for (int wi = w0; wi < w1; ++wi) {
                    const float* W; int K, N, nd64, mode; size_t dof;
                    switch (wi) {
                        case 0: W = a.in[2] + (size_t)l * 2048 * 11264; K = 2048; N = 11264; dof = WS_WA; nd64 = 176; mode = 1; break;
                        case 1: W = a.in[3] + (size_t)l * 5632 * 2048; K = 5632; N = 2048; dof = WS_WB; nd64 = 32; mode = 0; break;
                        case 2: W = a.in[5] + (size_t)l * 2048 * 12320; K = 2048; N = 12320; dof = WS_WC; nd64 = 196; mode = 2; break;
                        case 3: W = a.in[21] + (size_t)l * 512 * 2048; K = 512; N = 2048; dof = WS_WBRA; nd64 = 32; mode = 0; break;
                        case 4: W = a.in[22] + (size_t)l * 512 * 2048; K = 512; N = 2048; dof = WS_WBRB; nd64 = 32; mode = 0; break;
                        case 5: W = a.in[23] + (size_t)l * 1024 * 2048; K = 1024; N = 2048; dof = WS_WBRC; nd64 = 32; mode = 0; break;
                        case 6: W = a.in[24] + (size_t)l * 2048 * 2048; K = 2048; N = 2048; dof = WS_WO; nd64 = 32; mode = 0; break;
                        case 7: W = a.in[26] + (size_t)l * 2048 * 11264; K = 2048; N = 11264; dof = WS_WA; nd64 = 176; mode = 1; break;
                        default: W = a.in[27] + (size_t)l * 5632 * 2048; K = 5632; N = 2048; dof = WS_WB; nd64 = 32; mode = 0; break;
                    }
                    conv_w(W, K, N, (bf16_t*)(ws + dof), nd64, mode, (float*)smem);
                }
            }
            if (k == 0) {
                float* BIASP = (float*)(ws + WS_BIAS);
                for (int i = bid * 512 + ltid(); i < NP_; i += G * 512) {
                    const float* b = a.in[6] + (size_t)l * 12320;
                    BIASP[i] = i < 6144 ? b[i] : (i < 12288 ? b[6176 + (i - 6144)] : (i < 12320 ? b[6144 + (i - 12288)] : 0.f));
                }
#ifndef NO_H3
                hyena_h3(a, l, smem, (_Float16*)(ws + WS_H3));
#endif
            }
            if (k == 0 || k == 3 || k == 11) {
                const float* src = (k == 0 && l == 0) ? a.in[0] : OUT;
                const float* gw = (k == 0 ? a.in[1] : (k == 3 ? a.in[4] : a.in[25])) + l * 2048;
                rms_rows_bf16(src, gw, XN);
                if (k == 3 && G == 256) {
                    asm volatile("s_waitcnt vmcnt(0)" ::: "memory"); __syncthreads();
                    lr_proj(XN, (const bf16_t*)(ws + WS_WC), (const float*)(ws + WS_BIAS), (bf16_t*)(ws + WS_PLR), smem);
                }
            }
            if (k == 5) {
                branch_a_prep((const bf16_t*)(ws + WS_PA), a.in[7] + l * 1536, (bf16_t*)(ws + WS_AA));
                hyena_prep((const bf16_t*)(ws + WS_PA), a.in[8] + l * 4608, (bf16_t*)(ws + WS_ZT0), (bf16_t*)(ws + WS_G1T), (bf16_t*)(ws + WS_G2T));
#ifndef NO_C1
                gla_c1(a, l, smem, (const bf16_t*)(ws + WS_PC), (const bf16_t*)(ws + WS_PLR), (bf16_t*)(ws + WS_UPD), (float*)(ws + WS_DEC));
                hyena_filtgen(a, l, 0, (const _Float16*)(ws + WS_H3), (bf16_t*)(ws + WS_WC), (u64_t*)(ws + WS_FSUM) + (l * 2 + 0) * 1024);
#endif
            }
            if (k == 6 && rep == 0) gla_scan((bf16_t*)(ws + WS_UPD), (const float*)(ws + WS_DEC));
            if (k == 6 || k == 7) {
                const int o = k - 6;
#ifndef NO_CONV
                if (o == 0) hyena_filtgen(a, l, 1, (const _Float16*)(ws + WS_H3), (bf16_t*)(ws + WS_PA), (u64_t*)(ws + WS_FSUM) + (l * 2 + 1) * 1024);
                hyena_conv_mfma(a, l, o, smem, (const bf16_t*)(ws + (o ? WS_PA : WS_WC)), (const u64_t*)(ws + WS_FSUM) + (l * 2 + o) * 1024, (const bf16_t*)(ws + (o ? WS_ZT1 : WS_ZT0)), (const bf16_t*)(ws + (o ? WS_G2T : WS_G1T)), (bf16_t*)(ws + (o ? WS_Z2T : WS_ZT1)));
#endif
            }
#ifndef NO_C3
            if (k == 7) gla_c3(a, l, smem, (const bf16_t*)(ws + WS_PC), (const bf16_t*)(ws + WS_PLR), (const bf16_t*)(ws + WS_UPD), (bf16_t*)(ws + WS_OC));
#endif
            if (k == 8) { transpose_z((const bf16_t*)(ws + WS_Z2T), (bf16_t*)(ws + WS_ZT0), smem); __syncthreads(); }
            const int ng = (k == 1 || k == 2 || k == 4 || k == 9 || k == 10 || k == 12 || k == 13) ? 1 : (k == 8 ? 2 : 0);
            for (int gi = 0; gi < ng; ++gi) {
                pg8::Gemm g; EpiAll E;
                g.M = L_;
                E.gu.H = (bf16_t*)(ws + WS_P);
                E.rs.res = OUT; E.rs.out = OUT; E.rs.scale = 1.f;
                E.in.PA = (bf16_t*)(ws + WS_PA); E.in.PC = (bf16_t*)(ws + WS_PC); E.in.PG = PG; E.in.PLR = (bf16_t*)(ws + WS_PLR); E.in.bias = (const float*)(ws + WS_BIAS);
                E.br.Mg = XN; E.br.gate = PG; E.br.first = 0;
                if (k == 1 || k == 12) { g.A = XN; g.Bt = (const bf16_t*)(ws + WS_WA); g.N = 11264; g.K = 2048; E.mode = 0; }
                else if (k == 2 || k == 13) { g.A = (const bf16_t*)(ws + WS_P); g.Bt = (const bf16_t*)(ws + WS_WB); g.N = 2048; g.K = 5632; E.mode = 1; E.rs.scale = 0.5f; if (ph == 2) E.rs.res = a.in[0]; }
                else if (k == 4) { g.A = XN; g.Bt = (const bf16_t*)(ws + WS_WC); g.N = (G == 256) ? 12288 : NP_; g.K = 2048; E.mode = 2; }
                else if (k == 8 && gi == 0) { g.A = (const bf16_t*)(ws + WS_AA); g.Bt = (const bf16_t*)(ws + WS_WBRA); g.N = 2048; g.K = 512; E.mode = 3; E.br.first = 1; }
                else if (k == 8) { g.A = (const bf16_t*)(ws + WS_OC); g.Bt = (const bf16_t*)(ws + WS_WBRC); g.N = 2048; g.K = 1024; E.mode = 3; E.br.gate = PG + 4096; }
                else if (k == 9) { g.A = (const bf16_t*)(ws + WS_ZT0); g.Bt = (const bf16_t*)(ws + WS_WBRB); g.N = 2048; g.K = 512; E.mode = 3; E.br.gate = PG + 2048; }
                else { g.A = XN; g.Bt = (const bf16_t*)(ws + WS_WO); g.N = 2048; g.K = 2048; E.mode = 1; }
                pg8::StaticOrder S; S.init(L_, g.N, G, bid);
#ifndef NO_GEMM
                pg8::gemm_phase<EpiAll, pg8::StaticOrder>(lds, g, S, E);
#endif
            }
        }
        if (ph + 1 < a.ph_hi && ph + 1 < 29) { if (a.ph_hi < 0) grid.sync(); else xcd_barrier(xbar); }
    }
}

extern "C" void kernel_launch(void* const* d_in, const int* in_sizes, int n_in, void* d_out, int out_size, void* d_ws, size_t ws_size, hipStream_t stream) {
    static int grid_blocks = 0;
    if (!grid_blocks) {
        int dev = 0, cus = 0, per_cu = 0;
        hipGetDevice(&dev);
        hipDeviceGetAttribute(&cus, hipDeviceAttributeMultiprocessorCount, dev);
        if (hipFuncSetAttribute((const void*)mega, hipFuncAttributeMaxDynamicSharedMemorySize, LDS_BYTES) != hipSuccess) fprintf(stderr, "hipFuncSetAttribute failed\n");
        hipOccupancyMaxActiveBlocksPerMultiprocessor(&per_cu, (const void*)mega, 512, LDS_BYTES);
        (void)hipGetLastError();
        if (per_cu < 1) per_cu = 1;
        if (per_cu > 1) per_cu = 1;
        grid_blocks = cus * per_cu;
        if (ws_size < WS_END) fprintf(stderr, "workspace too small: %zu < %zu\n", ws_size, (size_t)WS_END);
    }
    Args a{};
    for (int i = 0; i < 29; ++i) a.in[i] = (const float*)d_in[i];
    a.out = (float*)d_out; a.ws = (unsigned char*)d_ws;
    (void)hipMemsetAsync((unsigned char*)d_ws + WS_CTL, 0, 49152, stream);
#if COOP
    a.ph_lo = 0; a.ph_hi = 1000;
    void* args[] = {&a};
    hipError_t e = hipLaunchCooperativeKernel((const void*)mega, dim3(grid_blocks), dim3(512), args, LDS_BYTES, stream);
    if (e != hipSuccess) fprintf(stderr, "cooperative launch failed: %s (grid %d)\n", hipGetErrorString(e), grid_blocks);
#else
    for (int p = 0; p < 29; ++p) { a.ph_lo = p; a.ph_hi = p + 1; hipLaunchKernelGGL(mega, dim3(grid_blocks), dim3(512), LDS_BYTES, stream, a); }
#endif
}
```
